# Optimizing an MI355X kernel written in HIP

```python
import math
import jax, jax.numpy as jnp
from jax import lax
import numpy as np

D_MODEL = 1024
BATCH = 32
SEQ = 256
DEPTH = 2
DEC_BATCH = 8
DEC_SEQ = 4096
PAST_LEN = 512

GRID_W = 64
N_HEADS = 8
N_KV_HEADS = 2
HEAD_DIM = 64
GQ = N_HEADS // N_KV_HEADS
ATTN_W = N_HEADS * HEAD_DIM
KV_W = N_KV_HEADS * HEAD_DIM
WINDOW = 128
BLOCK = 128
ROPE_BASE = 10000.0
ROPE_PAIRS = HEAD_DIM // 4
LRU_W = 512
LRU_BLOCKS = 8
LRU_BW = LRU_W // LRU_BLOCKS
LRU_C = 8.0
CONV_W = 4
CONV_LEFT = 2
S5_W = 512
S5_GROUP_CH = 16
S5_GROUPS = S5_W // S5_GROUP_CH
S5_N = 64
D_FF = 2816
N_MOD = 9
RMS_EPS = 1e-6
NEG_INF = -1e30
IN_SPLITS = (ATTN_W, ATTN_W + KV_W, ATTN_W + 2 * KV_W, ATTN_W + 2 * KV_W + LRU_W,
             ATTN_W + 2 * KV_W + 2 * LRU_W, ATTN_W + 2 * KV_W + 2 * LRU_W + S5_W)
IN_COLS = IN_SPLITS[-1] + 3 * D_MODEL

kernel_name = "hybrid_lru_s5_swa_diffusion_step"

F32 = jnp.float32


def _rms(x, g):
    xf = x.astype(F32)
    y = xf * lax.rsqrt(jnp.mean(xf * xf, axis=-1, keepdims=True) + RMS_EPS)
    return (y * g.astype(F32)).astype(x.dtype)


def _swiglu(h, wg, wu, wd):
    return (jax.nn.silu(h @ wg) * (h @ wu)) @ wd


def _axial_rope(x):
    T = x.shape[1]
    n_rows = T // GRID_W
    row = jnp.repeat(jnp.arange(n_rows), GRID_W).astype(F32)
    col = jnp.tile(jnp.arange(GRID_W), n_rows).astype(F32)
    inv = 1.0 / (ROPE_BASE ** (jnp.arange(ROPE_PAIRS, dtype=F32) / ROPE_PAIRS))

    def rot(xa, pos):
        ang = pos[:, None] * inv
        cos = jnp.cos(ang)[None, :, None, :]
        sin = jnp.sin(ang)[None, :, None, :]
        x1, x2 = jnp.split(xa, 2, axis=-1)
        return jnp.concatenate([x1 * cos - x2 * sin, x2 * cos + x1 * sin], axis=-1)

    xr, xc = jnp.split(x.astype(F32), 2, axis=-1)
    return jnp.concatenate([rot(xr, row), rot(xc, col)], axis=-1).astype(x.dtype)


def _scores(q, k):
    return jnp.einsum("bqhgd,bkhd->bhgqk", q.astype(F32), k.astype(F32)) * (HEAD_DIM ** -0.5)


def _sink_attend(scores, values, sink):
    sink_l = sink.astype(F32).reshape(1, N_KV_HEADS, GQ, 1)
    m = sink_l
    for s in scores:
        m = jnp.maximum(m, s.max(axis=-1))
    probs = [jnp.exp(s - m[..., None]) for s in scores]
    denom = jnp.exp(sink_l - m) + sum(p.sum(axis=-1) for p in probs)
    return sum(jnp.einsum("bhgqk,bkhd->bqhgd", p / denom[..., None], v.astype(F32))
               for p, v in zip(probs, values))


def _context_attention(q, k, v, sink):
    B, T = q.shape[:2]
    nb = T // BLOCK
    qb = jnp.moveaxis(q.reshape(B, nb, BLOCK, N_KV_HEADS, GQ, HEAD_DIM), 1, 0)
    o = lax.map(lambda qn: _sink_attend([_scores(qn, k)], [v], sink), qb)
    return jnp.moveaxis(o, 0, 1).reshape(B, T, ATTN_W)


def _latent_attention(q, k, v, ck, cv, sink):
    B, T = q.shape[:2]
    nb = T // BLOCK
    qb = jnp.moveaxis(q.reshape(B, nb, BLOCK, N_KV_HEADS, GQ, HEAD_DIM), 1, 0)

    def band(t):
        tp = jnp.pad(t, ((0, 0), (BLOCK, BLOCK), (0, 0), (0, 0)))
        tp = tp.reshape(B, nb + 2, BLOCK, N_KV_HEADS, HEAD_DIM)
        tb = jnp.concatenate([tp[:, :nb], tp[:, 1:nb + 1], tp[:, 2:]], axis=2)
        return jnp.moveaxis(tb, 1, 0)

    kb, vb = band(k), band(v)
    blk = jnp.arange(nb)[:, None, None]
    q_pos = blk * BLOCK + jnp.arange(BLOCK)[None, :, None]
    k_pos = (blk - 1) * BLOCK + jnp.arange(3 * BLOCK)[None, None, :]
    valid = (jnp.abs(k_pos - q_pos) <= WINDOW) & (k_pos >= 0) & (k_pos < T)

    def one_block(args):
        qn, kn, vn, mn = args
        s_loc = jnp.where(mn, _scores(qn, kn), NEG_INF)
        s_ctx = _scores(qn, ck)
        return _sink_attend([s_loc, s_ctx], [vn, cv], sink)

    o = lax.map(one_block, (qb, kb, vb, valid))
    return jnp.moveaxis(o, 0, 1).reshape(B, T, ATTN_W)


def _conv_centred(x, w, b):
    T = x.shape[1]
    xp = jnp.pad(x, ((0, 0), (CONV_LEFT, CONV_W - 1 - CONV_LEFT), (0, 0)))
    return sum(xp[:, j:j + T] * w[j] for j in range(CONV_W)) + b


def _blockdiag(x, w):
    B, T, _ = x.shape
    y = jnp.einsum("btnc,ncd->btnd", x.reshape(B, T, LRU_BLOCKS, LRU_BW), w.astype(F32))
    return y.reshape(B, T, LRU_W)


def _linear_scan(a, b, reverse):
    def combine(lo, hi):
        a_l, b_l = lo
        a_h, b_h = hi
        return a_l * a_h, a_h * b_l + b_h
    return lax.associative_scan(combine, (a, b), reverse=reverse, axis=1)[1]


def _complex_scan(a_re, a_im, b_re, b_im, reverse):
    def combine(lo, hi):
        ar_l, ai_l, br_l, bi_l = lo
        ar_h, ai_h, br_h, bi_h = hi
        return (ar_h * ar_l - ai_h * ai_l, ar_h * ai_l + ai_h * ar_l,
                ar_h * br_l - ai_h * bi_l + br_h, ar_h * bi_l + ai_h * br_l + bi_h)
    _, _, h_re, h_im = lax.associative_scan(combine, (a_re, a_im, b_re, b_im), reverse=reverse, axis=1)
    return h_re, h_im


def _rglru_branch(xl, yl, lp, init):
    dt = xl.dtype
    xc = _conv_centred(xl, lp["w_conv"], lp["b_conv"]).astype(F32)
    y = jnp.zeros_like(xc)
    finals = []
    for d, rev in enumerate((False, True)):
        r = jax.nn.sigmoid(_blockdiag(xc, lp["w_lru_a"][d]) + lp["b_lru_a"][d].astype(F32))
        i = jax.nn.sigmoid(_blockdiag(xc, lp["w_lru_x"][d]) + lp["b_lru_x"][d].astype(F32))
        log_a = -LRU_C * r * jax.nn.softplus(-lp["lru_lambda"][d].astype(F32))
        a = jnp.exp(log_a)
        b = jnp.sqrt(-jnp.expm1(2.0 * log_a)) * (i * xc)
        if init is not None:
            e0 = -1 if rev else 0
            b = b.at[:, e0].add(a[:, e0] * init[:, d].astype(F32))
        hs = _linear_scan(a, b, rev)
        y = y + hs
        if init is None:
            finals.append(hs[:, 0] if rev else hs[:, -1])
    out = y.astype(dt) * jax.nn.gelu(yl)
    fin = jnp.stack(finals, axis=1).astype(dt) if init is None else None
    return out, fin


def _s5_discretise(lam_re, lam_im, log_step, b_re, b_im):
    lam_re = jnp.minimum(lam_re.astype(F32), -1e-4)
    lam_im = lam_im.astype(F32)
    step = jnp.exp(log_step.astype(F32))[:, None]
    mag = jnp.exp(lam_re * step)
    ang = lam_im * step
    ab_re, ab_im = mag * jnp.cos(ang), mag * jnp.sin(ang)
    den = lam_re * lam_re + lam_im * lam_im
    num_re = ab_re - 1.0
    coef_re = (num_re * lam_re + ab_im * lam_im) / den
    coef_im = (ab_im * lam_re - num_re * lam_im) / den
    b_re, b_im = b_re.astype(F32), b_im.astype(F32)
    bb_re = coef_re[..., None] * b_re - coef_im[..., None] * b_im
    bb_im = coef_re[..., None] * b_im + coef_im[..., None] * b_re
    return ab_re, ab_im, bb_re, bb_im


def _s5_branch(u, lp, init):
    B, T, _ = u.shape
    dt = u.dtype
    uf = u.astype(F32).reshape(B, T, S5_GROUPS, S5_GROUP_CH)
    y = jnp.zeros_like(uf)
    finals = []
    for d, rev in enumerate((False, True)):
        ab_re, ab_im, bb_re, bb_im = _s5_discretise(lp["s5_lambda_re"][d], lp["s5_lambda_im"][d],
                                                    lp["s5_log_step"][d], lp["s5_b_re"][d], lp["s5_b_im"][d])
        b_re = jnp.einsum("btgc,gnc->btgn", uf, bb_re)
        b_im = jnp.einsum("btgc,gnc->btgn", uf, bb_im)
        if init is not None:
            e0 = -1 if rev else 0
            h0r = init[:, d, 0].astype(F32)
            h0i = init[:, d, 1].astype(F32)
            b_re = b_re.at[:, e0].add(ab_re * h0r - ab_im * h0i)
            b_im = b_im.at[:, e0].add(ab_re * h0i + ab_im * h0r)
        a_re = jnp.broadcast_to(ab_re, (1, T, S5_GROUPS, S5_N))
        a_im = jnp.broadcast_to(ab_im, (1, T, S5_GROUPS, S5_N))
        h_re, h_im = _complex_scan(a_re, a_im, b_re, b_im, rev)
        y = (y + jnp.einsum("btgn,gcn->btgc", h_re, lp["s5_c_re"][d].astype(F32))
               - jnp.einsum("btgn,gcn->btgc", h_im, lp["s5_c_im"][d].astype(F32)))
        if init is None:
            fe = 0 if rev else -1
            finals.append(jnp.stack([h_re[:, fe], h_im[:, fe]], axis=1))
    y = y.reshape(B, T, S5_W) + lp["s5_d"].astype(F32) * u.astype(F32)
    z = jax.nn.gelu(y).astype(dt) @ lp["w_glu"]
    za, zb = jnp.split(z, 2, axis=-1)
    fin = jnp.stack(finals, axis=1).astype(dt) if init is None else None
    return za * jax.nn.sigmoid(zb), fin


def _mixer(h, lp, ctx):
    B, T, _ = h.shape
    dt = h.dtype
    proj = h @ lp["w_in"]
    q, k, v, xl, yl, u, gates = jnp.split(proj, IN_SPLITS, axis=-1)
    q = q.reshape(B, T, N_HEADS, HEAD_DIM)
    k = k.reshape(B, T, N_KV_HEADS, HEAD_DIM)
    v = v.reshape(B, T, N_KV_HEADS, HEAD_DIM)
    if ctx is None:
        att = _context_attention(q, k, v, lp["attn_sink"])
        lru_init, ssm_init = None, None
    else:
        ck, cv, lru_init, ssm_init = ctx
        att = _latent_attention(_axial_rope(q), _axial_rope(k), v, ck, cv, lp["attn_sink"])
    lru_out, lru_fin = _rglru_branch(xl, yl, lp, lru_init)
    s5_out, ssm_fin = _s5_branch(u, lp, ssm_init)
    g_a, g_b, g_c = jnp.split(jax.nn.sigmoid(gates), 3, axis=-1)
    merged = (g_a * (lru_out @ lp["w_o_lru"]) + g_b * s5_out
              + g_c * (att.astype(dt) @ lp["w_o_attn"]))
    out = merged @ lp["w_out"]
    new_ctx = (k, v, lru_fin, ssm_fin) if ctx is None else None
    return out, new_ctx


def _layer(x, mod, lp, ctx):
    s0, c0, g0, s1, c1, g1, s2, c2, g2 = jnp.split(mod, N_MOD, axis=-1)
    h = _rms(x, lp["g_pre"][0]) * (1 + c0) + s0
    f = _swiglu(h, lp["w_ffn_gate"][0], lp["w_ffn_up"][0], lp["w_ffn_down"][0])
    x = x + 0.5 * g0 * _rms(f, lp["g_post"][0])
    h = _rms(x, lp["g_pre"][1]) * (1 + c1) + s1
    mix, new_ctx = _mixer(h, lp, ctx)
    x = x + g1 * _rms(mix, lp["g_post"][1])
    h = _rms(x, lp["g_pre"][2]) * (1 + c2) + s2
    f = _swiglu(h, lp["w_ffn_gate"][1], lp["w_ffn_up"][1], lp["w_ffn_down"][1])
    x = x + 0.5 * g2 * _rms(f, lp["g_post"][2])
    return x, new_ctx


def setup_inputs(seed: int = 0) -> dict:
    key = jax.random.key(seed)
    keys = iter(jax.random.split(key, 48))

    def nrm(shape, scale):
        return jax.random.normal(next(keys), shape, F32) * scale

    def unif(shape, lo, hi):
        return jax.random.uniform(next(keys), shape, F32, lo, hi)

    L = DEPTH
    x_prompt = nrm((BATCH, SEQ, D_MODEL), 1.0)
    x_sample = nrm((DEC_BATCH, DEC_SEQ, D_MODEL), 1.0)
    c = nrm((DEC_BATCH, D_MODEL), 1.0)
    cache_k = nrm((DEC_BATCH, L, PAST_LEN, N_KV_HEADS, HEAD_DIM), 1.0)
    cache_v = nrm((DEC_BATCH, L, PAST_LEN, N_KV_HEADS, HEAD_DIM), 1.0)
    state_lru = nrm((DEC_BATCH, L, 2, LRU_W), 0.5)
    state_ssm = nrm((DEC_BATCH, L, 2, 2, S5_GROUPS, S5_N), 0.1)
    c_ctx = nrm((D_MODEL,), 1.0)
    w_mod = nrm((L, D_MODEL, N_MOD * D_MODEL), 0.01)
    b_mod = nrm((L, N_MOD * D_MODEL), 0.02)
    g_pre = 1.0 + nrm((L, 3, D_MODEL), 0.02)
    g_post = 1.0 + nrm((L, 3, D_MODEL), 0.02)
    w_ffn_gate = nrm((L, 2, D_MODEL, D_FF), D_MODEL ** -0.5)
    w_ffn_up = nrm((L, 2, D_MODEL, D_FF), D_MODEL ** -0.5)
    w_ffn_down = nrm((L, 2, D_FF, D_MODEL), D_FF ** -0.5)
    w_in = nrm((L, D_MODEL, IN_COLS), D_MODEL ** -0.5)
    w_conv = nrm((L, CONV_W, LRU_W), CONV_W ** -0.5)
    b_conv = nrm((L, LRU_W), 0.02)
    w_lru_a = nrm((L, 2, LRU_BLOCKS, LRU_BW, LRU_BW), LRU_BW ** -0.5)
    b_lru_a = nrm((L, 2, LRU_W), 0.02)
    w_lru_x = nrm((L, 2, LRU_BLOCKS, LRU_BW, LRU_BW), LRU_BW ** -0.5)
    b_lru_x = nrm((L, 2, LRU_W), 0.02)
    a0 = unif((L, 2, LRU_W), 0.9, 0.999)
    lru_lambda = jnp.log(a0) - jnp.log1p(-a0)
    s5_lambda_re = -0.5 + nrm((L, 2, S5_GROUPS, S5_N), 0.01)
    s5_lambda_im = math.pi * jnp.arange(S5_N, dtype=F32) + nrm((L, 2, S5_GROUPS, S5_N), 0.01)
    s5_log_step = unif((L, 2, S5_GROUPS), math.log(1e-3), math.log(1e-1))
    s5_b_re = nrm((L, 2, S5_GROUPS, S5_N, S5_GROUP_CH), (2 * S5_GROUP_CH) ** -0.5)
    s5_b_im = nrm((L, 2, S5_GROUPS, S5_N, S5_GROUP_CH), (2 * S5_GROUP_CH) ** -0.5)
    s5_c_re = nrm((L, 2, S5_GROUPS, S5_GROUP_CH, S5_N), 0.5)
    s5_c_im = nrm((L, 2, S5_GROUPS, S5_GROUP_CH, S5_N), 0.5)
    s5_d = nrm((L, S5_W), 1.0)
    w_glu = nrm((L, S5_W, 2 * D_MODEL), S5_W ** -0.5)
    attn_sink = nrm((L, N_HEADS), 0.5)
    w_o_lru = nrm((L, LRU_W, D_MODEL), LRU_W ** -0.5)
    w_o_attn = nrm((L, ATTN_W, D_MODEL), ATTN_W ** -0.5)
    w_out = nrm((L, D_MODEL, D_MODEL), D_MODEL ** -0.5)
    return {"x_prompt": x_prompt, "x_sample": x_sample, "c": c,
            "cache_k": cache_k, "cache_v": cache_v, "state_lru": state_lru, "state_ssm": state_ssm,
            "c_ctx": c_ctx, "w_mod": w_mod, "b_mod": b_mod, "g_pre": g_pre, "g_post": g_post,
            "w_ffn_gate": w_ffn_gate, "w_ffn_up": w_ffn_up, "w_ffn_down": w_ffn_down,
            "w_in": w_in, "w_conv": w_conv, "b_conv": b_conv,
            "w_lru_a": w_lru_a, "b_lru_a": b_lru_a, "w_lru_x": w_lru_x, "b_lru_x": b_lru_x,
            "lru_lambda": lru_lambda, "s5_lambda_re": s5_lambda_re, "s5_lambda_im": s5_lambda_im,
            "s5_log_step": s5_log_step, "s5_b_re": s5_b_re, "s5_b_im": s5_b_im,
            "s5_c_re": s5_c_re, "s5_c_im": s5_c_im, "s5_d": s5_d, "w_glu": w_glu,
            "attn_sink": attn_sink, "w_o_lru": w_o_lru, "w_o_attn": w_o_attn, "w_out": w_out}


def reference(x_prompt, x_sample, c, cache_k, cache_v, state_lru, state_ssm, c_ctx, w_mod, b_mod,
              g_pre, g_post, w_ffn_gate, w_ffn_up, w_ffn_down, w_in, w_conv, b_conv,
              w_lru_a, b_lru_a, w_lru_x, b_lru_x, lru_lambda, s5_lambda_re, s5_lambda_im,
              s5_log_step, s5_b_re, s5_b_im, s5_c_re, s5_c_im, s5_d, w_glu, attn_sink,
              w_o_lru, w_o_attn, w_out):
    yp = x_prompt
    ys = x_sample
    new_k, new_v, new_lru, new_ssm = [], [], [], []
    for l in range(DEPTH):
        lp = {"g_pre": g_pre[l], "g_post": g_post[l], "w_ffn_gate": w_ffn_gate[l],
              "w_ffn_up": w_ffn_up[l], "w_ffn_down": w_ffn_down[l], "w_in": w_in[l],
              "w_conv": w_conv[l], "b_conv": b_conv[l], "w_lru_a": w_lru_a[l], "b_lru_a": b_lru_a[l],
              "w_lru_x": w_lru_x[l], "b_lru_x": b_lru_x[l], "lru_lambda": lru_lambda[l],
              "s5_lambda_re": s5_lambda_re[l], "s5_lambda_im": s5_lambda_im[l],
              "s5_log_step": s5_log_step[l], "s5_b_re": s5_b_re[l], "s5_b_im": s5_b_im[l],
              "s5_c_re": s5_c_re[l], "s5_c_im": s5_c_im[l], "s5_d": s5_d[l], "w_glu": w_glu[l],
              "attn_sink": attn_sink[l], "w_o_lru": w_o_lru[l], "w_o_attn": w_o_attn[l],
              "w_out": w_out[l]}
        mod_ctx = jax.nn.silu(c_ctx) @ w_mod[l] + b_mod[l]
        yp, (k_l, v_l, lru_l, ssm_l) = _layer(yp, mod_ctx, lp, None)
        new_k.append(k_l)
        new_v.append(v_l)
        new_lru.append(lru_l)
        new_ssm.append(ssm_l)
        mod_lat = (jax.nn.silu(c) @ w_mod[l] + b_mod[l])[:, None, :]
        ys, _ = _layer(ys, mod_lat, lp, (cache_k[:, l], cache_v[:, l], state_lru[:, l], state_ssm[:, l]))
    new_cache_k = jnp.stack(new_k, axis=1)
    new_cache_v = jnp.stack(new_v, axis=1)
    new_state_lru = jnp.stack(new_lru, axis=1)
    new_state_ssm = jnp.stack(new_ssm, axis=1)
    return (yp, ys, new_cache_k, new_cache_v, new_state_lru, new_state_ssm)
```

```cpp
#include <hip/hip_runtime.h>
#include <hip/hip_cooperative_groups.h>
#include <cstdio>
#include <cstdint>
namespace cg = cooperative_groups;
namespace pg8 {
#define PG8_LAS __attribute__((address_space(3)))
typedef unsigned short bf16_t;
typedef short bf16x8 __attribute__((ext_vector_type(8)));
typedef float f32x4 __attribute__((ext_vector_type(4)));
typedef unsigned u32x4 __attribute__((ext_vector_type(4)));
typedef unsigned u32x2 __attribute__((ext_vector_type(2)));
constexpr int BM = 256, BK = 64, HALF = 128, HTB = HALF * BK * 2, STAGE_BYTES = 8 * HTB, NXCD = 8, WGM = 8;
__host__ __device__ __forceinline__ int lds_byte(int r, int c) { const int st = (r >> 4) * 2 + (c >> 5), rr = r & 15, cc = c & 31, ob = rr * 64 + cc * 2; return st * 1024 + (ob ^ (((ob >> 9) & 1) << 5)); }
__host__ __device__ __forceinline__ void stage_rc(int b, int& R, int& C) { const int st = b / 1024, sb = b % 1024, swz = sb ^ (((sb >> 9) & 1) << 5); R = (st >> 1) * 16 + swz / 64; C = (st & 1) * 32 + (swz % 64) / 2; }
__host__ __device__ __forceinline__ int perm32(int rho) { const int n = rho >> 4, i = rho & 15; return 8 * (i >> 2) + 4 * n + (i & 3); }
__device__ __forceinline__ int opaque_tid() { int t = threadIdx.x; asm volatile("" : "+v"(t)); return t; }
struct Unit { int pm, pn; };
struct Gemm { const bf16_t* A; const bf16_t* Bt; int M, N, K, lda, ldb; };
struct Order {
    int nM, nN, nwg, G, c, i0, imax, batched;
    __device__ void init(int M, int N, int G_, int c_, int i0_ = 0, int imax_ = 1 << 30, int batched_ = 0) { nM = M / BM; nN = N / BM; nwg = batched_ ? nM : nM * nN; G = G_; c = c_; i0 = i0_; imax = imax_; batched = batched_; }
    __device__ bool next(int i, Unit& u) const {
        if (i >= imax) return false;
        const long L = (long)(i0 + i) * G + c; if (L >= nwg) return false;
        if (batched) { u.pm = (int)L; u.pn = (int)L / batched; return true; }
        int wgid = (int)L; { const int q = nwg / NXCD, r = nwg % NXCD, xcd = wgid % NXCD, off = wgid / NXCD; wgid = (xcd < r ? xcd * (q + 1) : r * (q + 1) + (xcd - r) * q) + off; }
        const int nig = WGM * nN, gid = wgid / nig, fm = gid * WGM, gsz = (nM - fm) < WGM ? (nM - fm) : WGM;
        u.pm = fm + ((wgid % nig) % gsz); u.pn = (wgid % nig) / gsz; return true;
    }
    __device__ __forceinline__ void a_ready(const Unit&) const {}
    __device__ __forceinline__ void done(const Unit&) const {}
};
__device__ __forceinline__ unsigned cvt_pk_bf16(float lo, float hi) { unsigned r; asm volatile("v_cvt_pk_bf16_f32 %0, %1, %2" : "=v"(r) : "v"(lo), "v"(hi)); return r; }
template <class Epi, class Sched, bool ALIGN_EPI = false, bool SP2 = false>
__device__ __forceinline__ void gemm_phase(PG8_LAS unsigned char* lds, const Gemm g, const Sched& S, const Epi& E) {
    const int tid = pg8::opaque_tid(), wid = __builtin_amdgcn_readfirstlane(tid >> 6), lane = tid & 63, wr = wid >> 2, wc = wid & 3, fr = lane & 15, fq = lane >> 4;
    const int K = g.K, nt = K / BK;
    unsigned voffA[2], voffB[2];
#pragma unroll
    for (int i = 0; i < 2; ++i) { int R, C; stage_rc(tid * 16 + i * 8192, R, C); const int Rb = Epi::PERM ? ((R & ~31) + perm32(R & 31)) : R;
        voffA[i] = (unsigned)(R * g.lda + C) * 2u; voffB[i] = (unsigned)(Rb * g.ldb + C) * 2u; }
    const size_t kstep = (size_t)(BK * 2);
    const size_t hstepA = (size_t)HALF * g.lda * 2, hstepB = (size_t)HALF * g.ldb * 2;
    const size_t tstepA = 2 * hstepA, tstepB = 2 * hstepB;
    const unsigned ldsw = (unsigned)wid * 1024u;
    const int aoff = lds_byte(wr * 64 + fr, fq * 8), boff = lds_byte(wc * 32 + fr, fq * 8);
#define PG8_SA(b, h) (((b) * 2 + (h)) * HTB)
#define PG8_SB(b, h) ((4 + (b) * 2 + (h)) * HTB)
#define PG8_STAGE(bufoff, gbase, voff) do { _Pragma("unroll") for (int _i = 0; _i < 2; ++_i) \
        __builtin_amdgcn_global_load_lds((const unsigned*)((const char*)(gbase) + (voff)[_i]), (PG8_LAS unsigned*)(lds + (bufoff) + ldsw + _i * 8192), 16, 0, 0); } while (0)
#define PG8_LDA(dst, b, h) do { _Pragma("unroll") for (int m = 0; m < 4; ++m) _Pragma("unroll") for (int k = 0; k < 2; ++k) dst[m][k] = *(const PG8_LAS bf16x8*)(lds + PG8_SA(b, h) + aoff + m * 2048 + k * 1024); } while (0)
#define PG8_LDB(dst, b, h) do { _Pragma("unroll") for (int n = 0; n < 2; ++n) _Pragma("unroll") for (int k = 0; k < 2; ++k) dst[n][k] = *(const PG8_LAS bf16x8*)(lds + PG8_SB(b, h) + boff + n * 2048 + k * 1024); } while (0)
#define PG8_MMA(ai, bj, At, Bt) do { __builtin_amdgcn_s_setprio(1); _Pragma("unroll") for (int m = 0; m < 4; ++m) _Pragma("unroll") for (int n = 0; n < 2; ++n) _Pragma("unroll") for (int k = 0; k < 2; ++k) \
        acc[ai][bj][m][n] = __builtin_amdgcn_mfma_f32_16x16x32_bf16(Bt[n][k], At[m][k], acc[ai][bj][m][n], 0, 0, 0); __builtin_amdgcn_s_setprio(0); } while (0)
#define PG8_WAIT_V(n) asm volatile("s_waitcnt vmcnt(" #n ")" ::: "memory")
#define PG8_WAIT_L(n) asm volatile("s_waitcnt lgkmcnt(" #n ")" ::: "memory")
#define PG8_BAR __builtin_amdgcn_s_barrier()
#define PG8_SCHED __builtin_amdgcn_sched_barrier(0)
    Unit cur, nxt; int ui = 0;
    if (!S.next(0, cur)) return;
    f32x4 acc[2][2][4][2];
#pragma unroll
    for (int a = 0; a < 2; ++a)
#pragma unroll
        for (int b = 0; b < 2; ++b)
#pragma unroll
            for (int m = 0; m < 4; ++m)
#pragma unroll
                for (int n = 0; n < 2; ++n) acc[a][b][m][n] = (f32x4){0.f, 0.f, 0.f, 0.f};
    bf16x8 At[4][2], B0[2][2], B1[2][2];
    const char* cA = (const char*)g.A + (size_t)cur.pm * tstepA; const char* cB = (const char*)g.Bt + (size_t)cur.pn * tstepB;
    S.a_ready(cur);
    if constexpr (SP2) {
        PG8_STAGE(PG8_SB(0, 0), cB, voffB); PG8_STAGE(PG8_SB(0, 1), cB + hstepB, voffB); PG8_STAGE(PG8_SA(0, 0), cA, voffA); PG8_STAGE(PG8_SA(0, 1), cA + hstepA, voffA);
        if (wr == 1) PG8_BAR;
        PG8_WAIT_V(2); PG8_BAR;
        PG8_STAGE(PG8_SB(1, 0), cB + kstep, voffB); PG8_STAGE(PG8_SA(1, 0), cA + kstep, voffA); PG8_STAGE(PG8_SB(1, 1), cB + hstepB + kstep, voffB);
        PG8_WAIT_V(6); PG8_BAR;
    } else {
        PG8_STAGE(PG8_SB(0, 0), cB, voffB); PG8_STAGE(PG8_SA(0, 0), cA, voffA); PG8_STAGE(PG8_SB(0, 1), cB + hstepB, voffB); PG8_STAGE(PG8_SA(0, 1), cA + hstepA, voffA);
        if (wr == 1) PG8_BAR;
        PG8_WAIT_V(4); PG8_BAR;
        PG8_STAGE(PG8_SB(1, 0), cB + kstep, voffB); PG8_STAGE(PG8_SA(1, 0), cA + kstep, voffA); PG8_STAGE(PG8_SB(1, 1), cB + hstepB + kstep, voffB);
        PG8_WAIT_V(6); PG8_BAR;
    }
    for (;;) {
        const bool has_next = S.next(ui + 1, nxt);
        const char* nA = has_next ? (const char*)g.A + (size_t)nxt.pm * tstepA : cA; const char* nB = has_next ? (const char*)g.Bt + (size_t)nxt.pn * tstepB : cB;
        for (int t = 0; t < nt; t += 2) {
            const bool last = (t == nt - 2);
            const char* a1 = cA + (size_t)(t + 1) * kstep;
            const char* a2 = last ? nA : cA + (size_t)(t + 2) * kstep; const char* b2 = last ? nB : cB + (size_t)(t + 2) * kstep;
            const char* a3 = a2 + kstep; const char* b3 = b2 + kstep;
            if (last && has_next) S.a_ready(nxt);
            if constexpr (SP2) {
            PG8_LDB(B0, 0, 0); PG8_LDB(B1, 0, 1); PG8_SCHED; PG8_LDA(At, 0, 0); PG8_STAGE(PG8_SA(1, 1), a1 + hstepA, voffA);
            PG8_WAIT_V(8); PG8_WAIT_L(0); PG8_BAR; PG8_MMA(0, 0, At, B0); PG8_MMA(0, 1, At, B1); PG8_BAR; PG8_SCHED;
            PG8_LDA(At, 0, 1); PG8_STAGE(PG8_SB(0, 0), b2, voffB); PG8_STAGE(PG8_SB(0, 1), b2 + hstepB, voffB); PG8_STAGE(PG8_SA(0, 0), a2, voffA);
            PG8_WAIT_V(8); PG8_WAIT_L(0); PG8_BAR; PG8_MMA(1, 0, At, B0); PG8_MMA(1, 1, At, B1); PG8_BAR; PG8_SCHED;
            PG8_LDB(B0, 1, 0); PG8_LDB(B1, 1, 1); PG8_SCHED; PG8_LDA(At, 1, 0); PG8_STAGE(PG8_SA(0, 1), a2 + hstepA, voffA);
            PG8_WAIT_V(8); PG8_WAIT_L(0); PG8_BAR; PG8_MMA(0, 0, At, B0); PG8_MMA(0, 1, At, B1); PG8_BAR; PG8_SCHED;
            PG8_LDA(At, 1, 1); PG8_STAGE(PG8_SB(1, 0), b3, voffB); PG8_STAGE(PG8_SB(1, 1), b3 + hstepB, voffB); PG8_STAGE(PG8_SA(1, 0), a3, voffA);
            PG8_WAIT_V(8); PG8_WAIT_L(0); PG8_BAR; PG8_MMA(1, 0, At, B0); PG8_MMA(1, 1, At, B1); PG8_BAR; PG8_SCHED;
            } else {
            PG8_LDB(B0, 0, 0); PG8_SCHED; PG8_LDA(At, 0, 0); PG8_STAGE(PG8_SA(1, 1), a1 + hstepA, voffA);
            PG8_WAIT_L(8); PG8_BAR; PG8_WAIT_L(0); PG8_MMA(0, 0, At, B0); PG8_BAR; PG8_SCHED;
            PG8_LDB(B1, 0, 1); PG8_STAGE(PG8_SB(0, 0), b2, voffB);
            PG8_BAR; PG8_WAIT_L(0); PG8_MMA(0, 1, At, B1); PG8_BAR;
            PG8_LDA(At, 0, 1); PG8_STAGE(PG8_SA(0, 0), a2, voffA);
            PG8_BAR; PG8_WAIT_L(0); PG8_MMA(1, 0, At, B0); PG8_BAR; PG8_SCHED;
            PG8_STAGE(PG8_SB(0, 1), b2 + hstepB, voffB);
            PG8_WAIT_V(6); PG8_BAR; PG8_MMA(1, 1, At, B1); PG8_BAR;
            PG8_LDB(B0, 1, 0); PG8_SCHED; PG8_LDA(At, 1, 0); PG8_STAGE(PG8_SA(0, 1), a2 + hstepA, voffA);
            PG8_WAIT_L(8); PG8_BAR; PG8_WAIT_L(0); PG8_MMA(0, 0, At, B0); PG8_BAR; PG8_SCHED;
            PG8_LDB(B1, 1, 1); PG8_STAGE(PG8_SB(1, 0), b3, voffB);
            PG8_BAR; PG8_WAIT_L(0); PG8_MMA(0, 1, At, B1); PG8_BAR;
            PG8_LDA(At, 1, 1); PG8_STAGE(PG8_SA(1, 0), a3, voffA);
            PG8_BAR; PG8_WAIT_L(0); PG8_MMA(1, 0, At, B0); PG8_BAR; PG8_SCHED;
            PG8_STAGE(PG8_SB(1, 1), b3 + hstepB, voffB);
            PG8_WAIT_V(6); PG8_BAR; PG8_MMA(1, 1, At, B1); PG8_BAR;
            }
        }
        if constexpr (ALIGN_EPI) { if (wr == 0) PG8_BAR; }
        if constexpr (!Epi::AFTER_DRAIN) { E(acc, cur, wr, wc, fr, fq); S.done(cur); }
        if (!has_next) break;
#pragma unroll
        for (int a = 0; a < 2; ++a)
#pragma unroll
            for (int b = 0; b < 2; ++b)
#pragma unroll
                for (int m = 0; m < 4; ++m)
#pragma unroll
                    for (int n = 0; n < 2; ++n) acc[a][b][m][n] = (f32x4){0.f, 0.f, 0.f, 0.f};
        cur = nxt; cA = nA; cB = nB; ++ui;
        if constexpr (ALIGN_EPI) { if (wr == 1) PG8_BAR; }
    }
    PG8_WAIT_V(0);
    if constexpr (!ALIGN_EPI) { if (wr == 0) PG8_BAR; }
    PG8_BAR;
    if constexpr (Epi::AFTER_DRAIN) { E.fused(acc, cur, wr, wc, fr, fq, lds, wid, lane); S.done(cur); }
#undef PG8_SA
#undef PG8_SB
#undef PG8_STAGE
#undef PG8_LDA
#undef PG8_LDB
#undef PG8_MMA
#undef PG8_WAIT_V
#undef PG8_WAIT_L
#undef PG8_BAR
#undef PG8_SCHED
}
}

using pg8::bf16_t; using pg8::f32x4; using pg8::u32x4; using pg8::u32x2; using pg8::bf16x8; using pg8::Unit; using pg8::cvt_pk_bf16;
#define LAS __attribute__((address_space(3)))
typedef float f32x2 __attribute__((ext_vector_type(2)));
constexpr int D = 1024, M = 40960, MCTX = 8192, FF = 2816, NIN = 2304, NT = 512, NWAVES = 8;
constexpr float LOG2E = 1.4426950408889634f, RMS_EPS = 1e-6f, QSCALE = 0.125f * 1.4426950408889634f;
constexpr size_t OUT_K = 41943040, OUT_V = 44040192, OUT_LRU = 46137344, OUT_SSM = 46202880;
constexpr int LDS_BYTES = 163840, MISC_OFF = 163840 - 256;
constexpr int NCHUNK = 2560;
constexpr size_t MiB = 1u << 20;
constexpr size_t WS_MOD = 1 * MiB, WS_ROPE = 2 * MiB, WS_APOW = 3 * MiB, WS_BBAR = 4 * MiB, WS_WL = 5 * MiB, WS_CK = 6 * MiB, WS_CVT = 7 * MiB, WS_AGG = 8 * MiB, WS_CIN = 13 * MiB,
    WS_TT = 16 * MiB, WS_PT = 24 * MiB, WS_WGU0 = 28 * MiB, WS_WGU1 = 39 * MiB, WS_WD0 = 50 * MiB, WS_WD1 = 50 * MiB + 5632 * 1024, WS_WIN = 61 * MiB, WS_WGLU = 61 * MiB + 10752 * 1024,
    WS_WOL = WS_WGLU + 2 * MiB, WS_WOA = WS_WOL + 1 * MiB, WS_WOUT = WS_WOA + 1 * MiB, WS_H = 78 * MiB, WS_F = 158 * MiB, WS_R = 238 * MiB, WS_F2 = 458 * MiB, WS_END = 474 * MiB;
constexpr int MSPLIT = 32768;
constexpr size_t WS_QB = WS_R, WS_YL = WS_R + 40 * MiB, WS_UH = WS_R + 80 * MiB, WS_S5Y = WS_R + 160 * MiB, WS_ACT = WS_R;
constexpr size_t WS_XL = WS_F, WS_KB = WS_F + 40 * MiB, WS_VT = WS_F + 50 * MiB, WS_MERGED = WS_F, WS_SCR = WS_UH;
static_assert(WS_WOUT + 2 * MiB <= WS_H, "ws map");

__device__ __forceinline__ float bf2f(unsigned h) { return __uint_as_float(h << 16); }
__device__ __forceinline__ float bflo(unsigned w) { return __uint_as_float(w << 16); }
__device__ __forceinline__ float bfhi(unsigned w) { return __uint_as_float(w & 0xffff0000u); }
__device__ __forceinline__ unsigned f2bf(float f) { unsigned u = __float_as_uint(f); return (u + 0x7fffu + ((u >> 16) & 1u)) >> 16; }
__device__ __forceinline__ float sigm(float x) { return 1.f / (1.f + __expf(-x)); }
__device__ __forceinline__ float sigm_f(float x) { return __builtin_amdgcn_rcpf(1.f + __builtin_amdgcn_exp2f(x * -1.4426950408889634f)); }
__device__ __forceinline__ float gelu_f(float x) { const float z = x * (1.0f + 0.044715f * x * x); return x * __builtin_amdgcn_rcpf(1.f + __builtin_amdgcn_exp2f(z * (-2.f * 0.7978845608028654f * 1.4426950408889634f))); }
__device__ __forceinline__ float gelu_t(float x) { const float z = 0.7978845608028654f * (x + 0.044715f * x * x * x); return x / (1.f + __expf(-2.f * z)); }
__device__ __forceinline__ float shx(float v, int mask, int lane) { return __int_as_float(__builtin_amdgcn_ds_bpermute((lane ^ mask) << 2, __float_as_int(v))); }
__device__ __forceinline__ float wave_sum(float v, int lane) {
#pragma unroll
    for (int o = 1; o < 64; o <<= 1) v += shx(v, o, lane);
    return v;
}
__device__ __forceinline__ u32x4 pack8(const f32x4 a, const f32x4 b) { u32x4 w; w.x = cvt_pk_bf16(a[0], a[1]); w.y = cvt_pk_bf16(a[2], a[3]); w.z = cvt_pk_bf16(b[0], b[1]); w.w = cvt_pk_bf16(b[2], b[3]); return w; }
__device__ __forceinline__ u32x2 pack4(const f32x4 a) { u32x2 w; w.x = cvt_pk_bf16(a[0], a[1]); w.y = cvt_pk_bf16(a[2], a[3]); return w; }

struct Params { const float* in[36]; float* out; unsigned char* ws; int ph_lo, ph_hi; };
typedef const __attribute__((address_space(4))) Params CParams;

#define XB_TMO      128
#define XB_XCNT(j)  (256  + 64 * (j))
#define XB_XSUB(j)  (1280 + 64 * (j))
#define XB_XGEN(j)  (2304 + 64 * (j))
#define XB_TOP      3328
#define XB_TOPGEN   3392
#define XCD_BAR_WORDS 3456
#define XB_SPIN_CAP (1u << 18)

__device__ __forceinline__ unsigned xb_ld(unsigned* p)              { return __hip_atomic_load(p, __ATOMIC_RELAXED, __HIP_MEMORY_SCOPE_AGENT); }
__device__ __forceinline__ unsigned xb_add(unsigned* p, unsigned v) { return __hip_atomic_fetch_add(p, v, __ATOMIC_RELAXED, __HIP_MEMORY_SCOPE_AGENT); }
__device__ __forceinline__ unsigned xb_xcc_id() { return (unsigned)__builtin_amdgcn_s_getreg((3 << 11) | 20) & 0xFu; }
#define XB_SPIN(cond, bar) do { unsigned _sp = 0; while (cond) { __builtin_amdgcn_s_sleep(1); \
    if ((++_sp & 255u) == 0u) { if (xb_ld(&(bar)[XB_TMO])) break; if (_sp > XB_SPIN_CAP) { atomicAdd(&(bar)[XB_TMO], 1u); break; } } } } while (0)

struct XcdBarrier {
    unsigned* bar; unsigned x;
    volatile LAS unsigned* st;
};

__device__ __forceinline__ XcdBarrier xcd_barrier_post(unsigned* bar, volatile LAS unsigned* st) {
    XcdBarrier b; b.bar = bar; b.x = xb_xcc_id(); b.st = st;
    if (threadIdx.x == 0) (void)xb_add(&bar[XB_XCNT(b.x)], 1u);
    return b;
}
__device__ __forceinline__ void xcd_barrier_complete(unsigned* bar, unsigned x, unsigned& nloc, unsigned& nx) {
    const unsigned G = gridDim.x * gridDim.y * gridDim.z;
    unsigned sum, cnt, mine, sp = 0u;
    for (;;) {
        sum = 0u; cnt = 0u; mine = 0u;
#pragma unroll
        for (unsigned j = 0; j < 16; ++j) { const unsigned c = xb_ld(&bar[XB_XCNT(j)]); sum += c; cnt += (c > 0u) ? 1u : 0u; mine = (j == x) ? c : mine; }
        if (sum == G) break;
        __builtin_amdgcn_s_sleep(1);
        if ((++sp & 255u) == 0u) { if (xb_ld(&bar[XB_TMO])) break; if (sp > XB_SPIN_CAP) { atomicAdd(&bar[XB_TMO], 1u); break; } }
    }
    nloc = mine > 0u ? mine : 1u; nx = cnt > 0u ? cnt : 1u;
}

__device__ __forceinline__ void xcd_barrier(const XcdBarrier& b) {
    asm volatile("s_waitcnt vmcnt(0)" ::: "memory");
    __syncthreads();
    if (threadIdx.x == 0) {
        unsigned* bar = b.bar;
        __builtin_amdgcn_s_waitcnt(0);
        unsigned nloc = b.st[0], nx = b.st[1];
        if (nloc == 0u) { xcd_barrier_complete(bar, b.x, nloc, nx); b.st[0] = nloc; b.st[1] = nx; }
        const unsigned old = xb_add(&bar[XB_XSUB(b.x)], 1u);
        const unsigned gen = old / nloc;
        if (old + 1u == (gen + 1u) * nloc) {
            __builtin_amdgcn_fence(__ATOMIC_RELEASE, "agent");
            asm volatile("s_waitcnt vmcnt(0)" ::: "memory");
            const unsigned og = xb_add(&bar[XB_TOP], 1u);
            const unsigned tg = og / nx;
            if (og + 1u == (tg + 1u) * nx) xb_add(&bar[XB_TOPGEN], 1u);
            else XB_SPIN(xb_ld(&bar[XB_TOPGEN]) == tg, bar);
            __builtin_amdgcn_fence(__ATOMIC_ACQUIRE, "agent");
            xb_add(&bar[XB_XGEN(b.x)], 1u);
            asm volatile("s_waitcnt vmcnt(0)" ::: "memory");
        } else {
            XB_SPIN(xb_ld(&bar[XB_XGEN(b.x)]) == gen, bar);
            __builtin_amdgcn_fence(__ATOMIC_ACQUIRE, "agent");
            asm volatile("s_waitcnt vmcnt(0)" ::: "memory");
        }
    }
    __syncthreads();
}

struct EpiPlain {
    static constexpr bool PERM = true, AFTER_DRAIN = false; bf16_t* O; int ldc;
    __device__ __forceinline__ void operator()(const f32x4 (&acc)[2][2][4][2], const Unit& u, int wr, int wc, int fr, int fq) const {
        const int row0 = u.pm * 256 + wr * 64 + fr, col0 = u.pn * 256 + wc * 32 + 8 * fq;
#pragma unroll
        for (int ai = 0; ai < 2; ++ai)
#pragma unroll
            for (int m = 0; m < 4; ++m) { bf16_t* rowp = O + (size_t)(row0 + ai * 128 + m * 16) * ldc + col0;
#pragma unroll
                for (int bj = 0; bj < 2; ++bj) *(u32x4*)(rowp + bj * 128) = pack8(acc[ai][bj][m][0], acc[ai][bj][m][1]); }
    }
};
struct EpiSwiGLU {
    static constexpr bool PERM = false, AFTER_DRAIN = false; bf16_t* O;
    __device__ __forceinline__ void operator()(const f32x4 (&acc)[2][2][4][2], const Unit& u, int wr, int wc, int fr, int fq) const {
        const int row0 = u.pm * 256 + wr * 64 + fr, col0 = u.pn * 128 + wc * 16 + 4 * fq;
#pragma unroll
        for (int ai = 0; ai < 2; ++ai)
#pragma unroll
            for (int m = 0; m < 4; ++m) { bf16_t* rowp = O + (size_t)(row0 + ai * 128 + m * 16) * FF + col0;
#pragma unroll
                for (int bj = 0; bj < 2; ++bj) { const f32x4 g = acc[ai][bj][m][0], up = acc[ai][bj][m][1]; f32x4 a;
#pragma unroll
                    for (int j = 0; j < 4; ++j) a[j] = g[j] * sigm_f(g[j]) * up[j];
                    *(u32x2*)(rowp + bj * 64) = pack4(a); } }
    }
};
struct EpiIn {
    static constexpr bool PERM = false, AFTER_DRAIN = false;
    bf16_t *QB, *KB, *VT, *XL, *YL, *UH; float* out; const float* rope; int l;
    __device__ __forceinline__ void operator()(const f32x4 (&acc)[2][2][4][2], const Unit& u, int wr, int wc, int fr, int fq) const {
        const int pn = u.pn; const bool lat = u.pm >= 32;
#pragma unroll
        for (int ai = 0; ai < 2; ++ai)
#pragma unroll
            for (int m = 0; m < 4; ++m) {
                const int row = u.pm * 256 + ai * 128 + wr * 64 + m * 16 + fr;
                const int t = lat ? ((row - MCTX) & 4095) : (row & 255);
#pragma unroll
                for (int bj = 0; bj < 2; ++bj) {
                    f32x4 v0 = acc[ai][bj][m][0], v1 = acc[ai][bj][m][1];
                    const int cb = 128 * bj + 32 * wc;
                    if (pn <= 2) {
                        const bool isq = pn < 2, isv = (pn == 2 && bj == 1);
                        if (lat && !isv) {
                            const int pos = (wc & 1) ? (t & 63) : (t >> 6);
                            const f32x4* rp = (const f32x4*)(rope + (pos * 16 + 4 * fq) * 2);
                            const f32x4 c01 = rp[0], c23 = rp[1];
                            const float cs[4] = {c01[0], c01[2], c23[0], c23[2]}, sn[4] = {c01[1], c01[3], c23[1], c23[3]};
#pragma unroll
                            for (int j = 0; j < 4; ++j) { const float x1 = v0[j], x2 = v1[j]; v0[j] = x1 * cs[j] - x2 * sn[j]; v1[j] = x2 * cs[j] + x1 * sn[j]; }
                        }
                        if (isq) { v0 = v0 * QSCALE; v1 = v1 * QSCALE; bf16_t* p = QB + (size_t)row * 512 + pn * 256 + cb + 4 * fq; *(u32x2*)p = pack4(v0); *(u32x2*)(p + 16) = pack4(v1); }
                        else {
                            const int kc = 32 * wc + 4 * fq;
                            if (!lat) { float* o = out + (bj ? OUT_V : OUT_K) + ((size_t)(((row >> 8) * 2 + l) * 256 + (row & 255))) * 128 + kc; *(f32x4*)o = v0; *(f32x4*)(o + 16) = v1; }
                            if (!isv) { bf16_t* p = KB + (size_t)row * 128 + kc; *(u32x2*)p = pack4(v0); *(u32x2*)(p + 16) = pack4(v1); }
                            else {
#pragma unroll
                                for (int j = 0; j < 4; ++j) { VT[(size_t)(kc + j) * M + row] = (bf16_t)f2bf(v0[j]); VT[(size_t)(kc + 16 + j) * M + row] = (bf16_t)f2bf(v1[j]); }
                            }
                        }
                    } else if (pn <= 6) {
                        bf16_t* p = (pn <= 4 ? XL : YL) + (size_t)row * 512 + ((pn - 3) & 1) * 256 + cb + 4 * fq; *(u32x2*)p = pack4(v0); *(u32x2*)(p + 16) = pack4(v1);
                    } else {
                        const int g0 = 16 * (pn - 7) + 8 * bj + 2 * wc;
                        bf16_t* p = UH + ((size_t)g0 * NCHUNK + (row >> 4)) * 512 + (row & 15) * 16 + 4 * fq;
                        *(u32x2*)p = pack4(v0); *(u32x2*)(p + (size_t)NCHUNK * 512) = pack4(v1);
                    }
                }
            }
    }
};
struct EpiS5State {
    static constexpr bool PERM = false, AFTER_DRAIN = true;
    bf16_t* UH; const float* apow; const float* init; float* out; int l;
    __device__ __forceinline__ void fused(f32x4 (&acc)[2][2][4][2], const Unit& u, int wr, int wc, int fr, int fq, PG8_LAS unsigned char* lds, int wid, int lane) const {
        const int g = u.pn, ti = u.pm - 10 * g, tid = wid * 64 + lane; const bool ctx = ti < 2;
        LAS float* T = (LAS float*)lds;
#pragma unroll
        for (int dir = 0; dir < 2; ++dir) {
#pragma unroll
            for (int ai = 0; ai < 2; ++ai)
#pragma unroll
                for (int m = 0; m < 4; ++m)
#pragma unroll
                    for (int n = 0; n < 2; ++n) *(LAS f32x4*)(T + (ai * 128 + wr * 64 + m * 16 + fr) * 132 + 32 * wc + 16 * n + 4 * fq) = acc[ai][dir][m][n];
            __syncthreads();
            if (tid < 64) {
                const int n = tid; const float* ap = apow + ((((size_t)dir * 32 + g) * 64 + n) * 17 + 16) * 2; const float ar = ap[0], aim = ap[1];
                float hr = 0.f, hi = 0.f;
                if (!ctx) { const size_t ib = ((((size_t)(ti - 2) * 2 + l) * 2 + dir) * 2) * 2048 + g * 64 + n; hr = init[ib]; hi = init[ib + 2048]; }
                for (int c0 = 0; c0 < 256; c0 += 8) {
                    float sr[8], si[8];
#pragma unroll
                    for (int k = 0; k < 8; ++k) { const int c = dir ? 255 - (c0 + k) : c0 + k; sr[k] = T[c * 132 + n]; si[k] = T[c * 132 + 64 + n]; }
#pragma unroll
                    for (int k = 0; k < 8; ++k) { const int cc = c0 + k, c = dir ? 255 - cc : cc;
                        if (ctx && (cc & 15) == 0) { hr = 0.f; hi = 0.f; }
                        T[c * 132 + n] = hr; T[c * 132 + 64 + n] = hi;
                        const float nr = ar * hr - aim * hi + sr[k], ni = ar * hi + aim * hr + si[k]; hr = nr; hi = ni;
                        if (ctx && (cc & 15) == 15) { const int seq = ti * 16 + (c >> 4); const size_t ob = OUT_SSM + ((((size_t)seq * 2 + l) * 2 + dir) * 2) * 2048 + g * 64 + n; out[ob] = hr; out[ob + 2048] = hi; }
                    }
                }
            }
            __syncthreads();
            { const int row = tid >> 1, half = tid & 1; const LAS float* s = T + row * 132 + half * 64;
              bf16_t* d = UH + ((size_t)g * NCHUNK + ti * 256 + row) * 512 + 256 + dir * 128 + half * 64;
#pragma unroll
              for (int c8 = 0; c8 < 8; ++c8) { const f32x4 a = *(const LAS f32x4*)(s + c8 * 8), b = *(const LAS f32x4*)(s + c8 * 8 + 4); *(u32x4*)(d + c8 * 8) = pack8(a, b); } }
            __syncthreads();
        }
    }
};
struct EpiS5Out {
    static constexpr bool PERM = true, AFTER_DRAIN = false; const bf16_t* UH; bf16_t* S5Y; const float* dvec;
    __device__ __forceinline__ void operator()(const f32x4 (&acc)[2][2][4][2], const Unit& u, int wr, int wc, int fr, int fq) const {
        const int g = u.pn, ti = u.pm - 10 * g, co0 = 8 * (fq & 1);
        const f32x4 d0 = *(const f32x4*)(dvec + 16 * g + co0), d1 = *(const f32x4*)(dvec + 16 * g + co0 + 4);
#pragma unroll
        for (int ai = 0; ai < 2; ++ai)
#pragma unroll
            for (int m = 0; m < 4; ++m) { const int cidx = ti * 256 + ai * 128 + wr * 64 + m * 16 + fr;
#pragma unroll
                for (int bj = 0; bj < 2; ++bj) { const int t = 8 * bj + 2 * wc + (fq >> 1);
                    const u32x4 uu = *(const u32x4*)(UH + ((size_t)g * NCHUNK + cidx) * 512 + t * 16 + co0);
                    f32x4 a = acc[ai][bj][m][0], b = acc[ai][bj][m][1];
                    a[0] = gelu_f(a[0] + d0[0] * bflo(uu.x)); a[1] = gelu_f(a[1] + d0[1] * bfhi(uu.x)); a[2] = gelu_f(a[2] + d0[2] * bflo(uu.y)); a[3] = gelu_f(a[3] + d0[3] * bfhi(uu.y));
                    b[0] = gelu_f(b[0] + d1[0] * bflo(uu.z)); b[1] = gelu_f(b[1] + d1[1] * bfhi(uu.z)); b[2] = gelu_f(b[2] + d1[2] * bflo(uu.w)); b[3] = gelu_f(b[3] + d1[3] * bfhi(uu.w));
                    *(u32x4*)(S5Y + ((size_t)cidx * 16 + t) * 512 + 16 * g + co0) = pack8(a, b); }
                asm volatile("" ::: "memory"); }
    }
};
template <int MODE> struct EpiMerge {
    static constexpr bool PERM = true, AFTER_DRAIN = false; u32x4* scr; bf16_t* O;
    __device__ __forceinline__ void operator()(const f32x4 (&acc)[2][2][4][2], const Unit& u, int wr, int wc, int fr, int fq) const {
        const int tid = pg8::opaque_tid(); u32x4* G = scr + tid; u32x4* MG = scr + 8192 + tid;
        const int row0 = u.pm * 256 + wr * 64 + fr, col0 = u.pn * 256 + wc * 32 + 8 * fq;
#pragma unroll
        for (int ai = 0; ai < 2; ++ai)
#pragma unroll
            for (int m = 0; m < 4; ++m)
#pragma unroll
                for (int bj = 0; bj < 2; ++bj) { const int i = (ai * 4 + m) * 2 + bj; f32x4 a = acc[ai][bj][m][0], b = acc[ai][bj][m][1];
                    if (MODE == 0) {
#pragma unroll
                        for (int j = 0; j < 4; ++j) { a[j] = sigm_f(a[j]); b[j] = sigm_f(b[j]); }
                        G[i * 512] = pack8(a, b);
                    } else {
                        const u32x4 gw = G[i * 512]; const f32x4 ga = {bflo(gw.x), bfhi(gw.x), bflo(gw.y), bfhi(gw.y)}, gb = {bflo(gw.z), bfhi(gw.z), bflo(gw.w), bfhi(gw.w)};
                        if (MODE == 1) MG[i * 512] = pack8(ga * a, gb * b);
                        else if (MODE == 2) G[i * 512] = pack8(ga * a, gb * b);
                        else { const u32x4 mw = MG[i * 512]; const f32x4 ma = {bflo(mw.x), bfhi(mw.x), bflo(mw.y), bfhi(mw.y)}, mb = {bflo(mw.z), bfhi(mw.z), bflo(mw.w), bfhi(mw.w)};
                            if (MODE == 3) {
#pragma unroll
                                for (int j = 0; j < 4; ++j) { a[j] = sigm_f(a[j]); b[j] = sigm_f(b[j]); }
                                MG[i * 512] = pack8(ma + ga * a, mb + gb * b);
                            } else *(u32x4*)(O + (size_t)(row0 + ai * 128 + m * 16) * D + col0 + bj * 128) = pack8(ma + ga * a, mb + gb * b);
                        }
                    }
                    if (bj == 1) asm volatile("" ::: "memory");
                }
    }
};

struct MergeOrder {
    pg8::Order base; int mode;
    __device__ bool next(int i, Unit& u) const {
        Unit t; if (!base.next(0, t)) return false;
        if (mode == 0) { if (i >= 3) return false; u.pm = t.pm; u.pn = t.pn + 4 * i; return true; }
        if (i >= 4) return false;
        if (i == 0) { u.pm = t.pm + 160; u.pn = 8 + t.pn; } else if (i == 1) { u.pm = t.pm + 640; u.pn = t.pn; } else if (i == 2) { u.pm = t.pm + 640; u.pn = 4 + t.pn; } else { u.pm = t.pm; u.pn = 12 + t.pn; }
        return true;
    }
    __device__ __forceinline__ void a_ready(const Unit&) const {}
    __device__ __forceinline__ void done(const Unit&) const {}
};
__device__ __forceinline__ void unpack8(const u32x4 w, f32x4& a, f32x4& b) { a = (f32x4){bflo(w.x), bfhi(w.x), bflo(w.y), bfhi(w.y)}; b = (f32x4){bflo(w.z), bfhi(w.z), bflo(w.w), bfhi(w.w)}; }
#define SLOT2(i) ((i) < 8 ? s2lo + (i) * 512 : s2hi + ((i) - 8) * 512)
struct EpiGates {
    static constexpr bool PERM = true, AFTER_DRAIN = false; u32x4 *s01, *s2lo, *s2hi;
    __device__ __forceinline__ void operator()(const f32x4 (&acc)[2][2][4][2], const Unit& u, int wr, int wc, int fr, int fq) const {
        const int tid = pg8::opaque_tid(), kind = u.pn >> 2;
#pragma unroll
        for (int ai = 0; ai < 2; ++ai)
#pragma unroll
            for (int m = 0; m < 4; ++m)
#pragma unroll
                for (int bj = 0; bj < 2; ++bj) { const int i = (ai * 4 + m) * 2 + bj; f32x4 a = acc[ai][bj][m][0], b = acc[ai][bj][m][1];
#pragma unroll
                    for (int j = 0; j < 4; ++j) { a[j] = sigm(a[j]); b[j] = sigm(b[j]); }
                    u32x4* d = kind == 0 ? s01 + i * 512 : (kind == 1 ? s01 + 8192 + i * 512 : SLOT2(i));
                    d[tid] = pack8(a, b); }
    }
};
struct EpiMix {
    static constexpr bool PERM = true, AFTER_DRAIN = false; u32x4 *s01, *s2lo, *s2hi; bf16_t* O;
    __device__ __forceinline__ void operator()(const f32x4 (&acc)[2][2][4][2], const Unit& u, int wr, int wc, int fr, int fq) const {
        const int tid = pg8::opaque_tid(), kind = u.pn >> 2;
        const int opm = u.pm % 160, opn = u.pn & 3, row0 = opm * 256 + wr * 64 + fr, col0 = opn * 256 + wc * 32 + 8 * fq;
#pragma unroll
        for (int ai = 0; ai < 2; ++ai)
#pragma unroll
            for (int m = 0; m < 4; ++m) {
#pragma unroll
                for (int bj = 0; bj < 2; ++bj) { const int i = (ai * 4 + m) * 2 + bj; f32x4 a = acc[ai][bj][m][0], b = acc[ai][bj][m][1];
                    u32x4* p0 = s01 + i * 512 + tid; u32x4* p1 = p0 + 8192; u32x4* p2 = SLOT2(i) + tid;
                    if (kind == 2) { f32x4 ga, gb; unpack8(*p0, ga, gb); *p0 = pack8(ga * a, gb * b); }
                    else if (kind == 0) { f32x4 ga, gb; unpack8(*p1, ga, gb); *p1 = pack8(ga * a, gb * b); }
                    else if (kind == 1) { f32x4 ga, gb, ma, mb; unpack8(*p1, ga, gb); unpack8(*p0, ma, mb);
#pragma unroll
                        for (int j = 0; j < 4; ++j) { a[j] = sigm(a[j]); b[j] = sigm(b[j]); }
                        *p0 = pack8(ma + ga * a, mb + gb * b); }
                    else { f32x4 ga, gb, ma, mb; unpack8(*p2, ga, gb); unpack8(*p0, ma, mb);
                        *(u32x4*)(O + (size_t)(row0 + ai * 128 + m * 16) * D + col0 + bj * 128) = pack8(ma + ga * a, mb + gb * b); }
                }
                asm volatile("" ::: "memory"); }
    }
};
__device__ __forceinline__ void transpose_item(const float* W, int K, int N, bf16_t* WT, int mode, LAS float* scr, int item, int lane) {
    const int nblk = N / 32, kb = item / nblk, nb = item % nblk, k0 = 64 * kb, n0 = 32 * nb;
#pragma unroll 8
    for (int i = 0; i < 32; ++i) { const int kk = 2 * i + (lane >> 5); scr[kk * 33 + (lane & 31)] = W[(size_t)(k0 + kk) * N + n0 + (lane & 31)]; }
    asm volatile("s_waitcnt lgkmcnt(0)" ::: "memory");
    const int c = lane & 7;
#pragma unroll
    for (int j = 0; j < 4; ++j) { const int n = (lane >> 3) + 8 * j; const LAS float* s = scr + (8 * c) * 33 + n;
        u32x4 o; o.x = cvt_pk_bf16(s[0 * 33], s[1 * 33]); o.y = cvt_pk_bf16(s[2 * 33], s[3 * 33]); o.z = cvt_pk_bf16(s[4 * 33], s[5 * 33]); o.w = cvt_pk_bf16(s[6 * 33], s[7 * 33]);
        const int gn = n0 + n, drow = mode == 0 ? gn : ((gn >> 4) * 32 + (gn & 15) + (mode == 2 ? 16 : 0));
        *(u32x4*)(WT + (size_t)drow * K + k0 + 8 * c) = o; }
    asm volatile("s_waitcnt lgkmcnt(0)" ::: "memory");
}
__device__ __forceinline__ void prep_phase(CParams& p, int l, LAS unsigned char* lds, const int G, const int bx) {
    const int tid = pg8::opaque_tid(), lane = tid & 63, wave = tid >> 6;
    unsigned char* ws = p.ws;
    {
        LAS float* scr = (LAS float*)(lds + wave * 8704);
        const int gw = bx * NWAVES + wave, NGW = G * NWAVES;
        constexpr int I_G = 16 * 88, I_D = 44 * 32, I_IN = 16 * 168, I_GLU = 8 * 64, I_O = 8 * 32, I_OUT = 16 * 32;
        constexpr int NITEMS = 4 * I_G + 2 * I_D + I_IN + I_GLU + 2 * I_O + I_OUT;
        const float* wg = p.in[12] + (size_t)l * 2 * D * FF; const float* wu = p.in[13] + (size_t)l * 2 * D * FF; const float* wd = p.in[14] + (size_t)l * 2 * FF * D;
        for (int it = gw; it < NITEMS; it += NGW) {
            int r = it;
            if (r < I_G) { transpose_item(wg, D, FF, (bf16_t*)(ws + WS_WGU0), 1, scr, r, lane); continue; } r -= I_G;
            if (r < I_G) { transpose_item(wu, D, FF, (bf16_t*)(ws + WS_WGU0), 2, scr, r, lane); continue; } r -= I_G;
            if (r < I_G) { transpose_item(wg + (size_t)D * FF, D, FF, (bf16_t*)(ws + WS_WGU1), 1, scr, r, lane); continue; } r -= I_G;
            if (r < I_G) { transpose_item(wu + (size_t)D * FF, D, FF, (bf16_t*)(ws + WS_WGU1), 2, scr, r, lane); continue; } r -= I_G;
            if (r < I_D) { transpose_item(wd, FF, D, (bf16_t*)(ws + WS_WD0), 0, scr, r, lane); continue; } r -= I_D;
            if (r < I_D) { transpose_item(wd + (size_t)FF * D, FF, D, (bf16_t*)(ws + WS_WD1), 0, scr, r, lane); continue; } r -= I_D;
            if (r < I_IN) { transpose_item(p.in[15] + (size_t)l * D * 5376, D, 5376, (bf16_t*)(ws + WS_WIN), 0, scr, r, lane); continue; } r -= I_IN;
            if (r < I_GLU) { transpose_item(p.in[31] + (size_t)l * 512 * 2048, 512, 2048, (bf16_t*)(ws + WS_WGLU), 0, scr, r, lane); continue; } r -= I_GLU;
            if (r < I_O) { transpose_item(p.in[33] + (size_t)l * 512 * D, 512, D, (bf16_t*)(ws + WS_WOL), 0, scr, r, lane); continue; } r -= I_O;
            if (r < I_O) { transpose_item(p.in[34] + (size_t)l * 512 * D, 512, D, (bf16_t*)(ws + WS_WOA), 0, scr, r, lane); continue; } r -= I_O;
            transpose_item(p.in[35] + (size_t)l * D * D, D, D, (bf16_t*)(ws + WS_WOUT), 0, scr, r, lane);
        }
    }
    const int gt = bx * NT + tid, NGT = G * NT;
    for (int i = gt; i < 4096; i += NGT) {
        const int dir = i >> 11, g = (i >> 6) & 31;
        const size_t li = ((size_t)l * 2 + dir) * 2048 + (i & 2047);
        const float lre = fminf(p.in[23][li], -1e-4f), lim = p.in[24][li], step = __expf(p.in[25][((size_t)l * 2 + dir) * 32 + g]);
        float* ap = (float*)(ws + WS_APOW) + (size_t)i * 34;
        const float mag1 = __expf(lre * step), ang1 = lim * step, abr = mag1 * __cosf(ang1), abi = mag1 * __sinf(ang1);
        { float pr = 1.f, pi = 0.f; for (int j = 0; j <= 16; ++j) { ap[2 * j] = pr; ap[2 * j + 1] = pi; const float nr = pr * abr - pi * abi, ni = pr * abi + pi * abr; pr = nr; pi = ni; } }
        const float den = lre * lre + lim * lim, nre = abr - 1.f;
        const float cre = (nre * lre + abi * lim) / den, cim = (abi * lre - nre * lim) / den;
        float* bb = (float*)(ws + WS_BBAR) + (size_t)i * 32;
        for (int ci = 0; ci < 16; ++ci) { const float br = p.in[26][li * 16 + ci], bi = p.in[27][li * 16 + ci]; bb[2 * ci] = cre * br - cim * bi; bb[2 * ci + 1] = cre * bi + cim * br; }
    }
    for (int i = gt; i < 8 * 512 * 128; i += NGT) {
        const int b = i >> 16, key = (i >> 7) & 511, c = i & 127, kvh = c >> 6, d = c & 63;
        const size_t src = (((size_t)b * 2 + l) * 512 + key) * 128 + c;
        ((bf16_t*)(ws + WS_CK))[(((size_t)b * 2 + kvh) * 512 + key) * 64 + d] = (bf16_t)f2bf(p.in[3][src]);
        ((bf16_t*)(ws + WS_CVT))[(((size_t)b * 2 + kvh) * 64 + d) * 512 + key] = (bf16_t)f2bf(p.in[4][src]);
    }
    for (int i = gt; i < 2 * 2 * 8 * 4096; i += NGT) {
        const int dir = i >> 16, gate = (i >> 15) & 1, blk = (i >> 12) & 7, o = (i >> 6) & 63, c = i & 63;
        const float* w = gate ? p.in[20] : p.in[18];
        ((bf16_t*)(ws + WS_WL))[i] = (bf16_t)f2bf(w[((((size_t)l * 2 + dir) * 8 + blk) * 64 + c) * 64 + o]);
    }
    if (l == 0) {
        for (int i = gt; i < 1024; i += NGT) { const int pos = i >> 4, k = i & 15; const float inv = __builtin_amdgcn_exp2f(-(float)k * (13.287712379549449f / 16.0f)); const float cs = __cosf((float)pos * inv), sn = __sinf((float)pos * inv);
            ((float*)(ws + WS_ROPE))[2 * i] = cs; ((float*)(ws + WS_ROPE))[2 * i + 1] = sn; }
        __syncthreads();
        LAS float* sv = (LAS float*)lds;
        LAS float* red = (LAS float*)(lds + 36864);
        for (int i = tid; i < 9 * 1024; i += NT) { const int v = i >> 10, k = i & 1023; const float x = v == 0 ? p.in[7][k] : p.in[2][(v - 1) * 1024 + k]; sv[i] = x * sigm(x); }
        __syncthreads();
        for (int it = bx; it < 288; it += G) {
            const int ll = it / 144, n0 = (it % 144) * 64, ks = tid >> 6, col = tid & 63;
            const float* w = p.in[8] + (size_t)ll * D * 9216 + n0 + col;
            float a[9];
#pragma unroll
            for (int v = 0; v < 9; ++v) a[v] = 0.f;
            for (int k = ks * 128; k < ks * 128 + 128; ++k) { const float wv = w[(size_t)k * 9216];
#pragma unroll
                for (int v = 0; v < 9; ++v) a[v] += sv[v * 1024 + k] * wv; }
#pragma unroll
            for (int v = 0; v < 9; ++v) red[(ks * 9 + v) * 64 + col] = a[v];
            __syncthreads();
            for (int i = tid; i < 576; i += NT) { const int v = i >> 6, cc = i & 63; float s = p.in[9][(size_t)ll * 9216 + n0 + cc];
#pragma unroll
                for (int k2 = 0; k2 < 8; ++k2) s += red[(k2 * 9 + v) * 64 + cc];
                ((float*)(ws + WS_MOD))[((size_t)ll * 9 + v) * 9216 + n0 + cc] = s; }
            __syncthreads();
        }
    }
}
__device__ __forceinline__ void prep2_phase(CParams& p, int l, const int G, const int bx) {
    const int tid = pg8::opaque_tid(), gt = bx * NT + tid, NGT = G * NT;
    const float* apow = (const float*)(p.ws + WS_APOW); const float* bbar = (const float*)(p.ws + WS_BBAR);
    bf16_t* TT = (bf16_t*)(p.ws + WS_TT); bf16_t* PT = (bf16_t*)(p.ws + WS_PT);
    for (int i = gt; i < 32 * 16 * 16 * 16; i += NGT) {
        const int s = i & 15, co = (i >> 4) & 15, t = (i >> 8) & 15, g = i >> 12;
        float a[16];
#pragma unroll
        for (int ci = 0; ci < 16; ++ci) a[ci] = 0.f;
#pragma unroll
        for (int dir = 0; dir < 2; ++dir) {
            if (dir == 0 ? (s > t) : (s < t)) continue;
            const int j = dir == 0 ? t - s : s - t;
            const float* cre = p.in[28] + ((((size_t)l * 2 + dir) * 32 + g) * 16 + co) * 64; const float* cim = p.in[29] + ((((size_t)l * 2 + dir) * 32 + g) * 16 + co) * 64;
            const float* ap = apow + (((size_t)dir * 32 + g) * 64) * 34 + 2 * j; const float* bb = bbar + (((size_t)dir * 32 + g) * 64) * 32;
            for (int n = 0; n < 64; ++n) {
                const float cr = cre[n], cm = cim[n], pr = ap[n * 34], pi = ap[n * 34 + 1];
                const float wr_ = cr * pr - cm * pi, wi_ = cr * pi + cm * pr;
                const f32x4* b4 = (const f32x4*)(bb + n * 32);
#pragma unroll
                for (int q = 0; q < 8; ++q) { const f32x4 v = b4[q]; a[2 * q] += wr_ * v[0] - wi_ * v[1]; a[2 * q + 1] += wr_ * v[2] - wi_ * v[3]; }
            }
        }
        bf16_t* d = TT + ((size_t)g * 256 + t * 16 + co) * 512 + s * 16;
        u32x4 o0, o1; o0.x = cvt_pk_bf16(a[0], a[1]); o0.y = cvt_pk_bf16(a[2], a[3]); o0.z = cvt_pk_bf16(a[4], a[5]); o0.w = cvt_pk_bf16(a[6], a[7]);
        o1.x = cvt_pk_bf16(a[8], a[9]); o1.y = cvt_pk_bf16(a[10], a[11]); o1.z = cvt_pk_bf16(a[12], a[13]); o1.w = cvt_pk_bf16(a[14], a[15]);
        *(u32x4*)d = o0; *(u32x4*)(d + 8) = o1;
    }
    for (int i = gt; i < 32 * 256 * 128; i += NGT) {
        const int n = i & 63, dir = (i >> 6) & 1, co = (i >> 7) & 15, t = (i >> 11) & 15, g = i >> 15;
        const size_t cb = ((((size_t)l * 2 + dir) * 32 + g) * 16 + co) * 64 + n; const float cr = p.in[28][cb], cm = p.in[29][cb];
        const float* ap = apow + (((size_t)dir * 32 + g) * 64 + n) * 34 + 2 * (dir == 0 ? t + 1 : 16 - t);
        const float wr_ = cr * ap[0] - cm * ap[1], wi_ = cr * ap[1] + cm * ap[0];
        bf16_t* d = TT + ((size_t)g * 256 + t * 16 + co) * 512 + 256 + dir * 128 + n;
        d[0] = (bf16_t)f2bf(wr_); d[64] = (bf16_t)f2bf(-wi_);
    }
    for (int i = gt; i < 32 * 2 * 64 * 256; i += NGT) {
        const int ci = i & 15, s = (i >> 4) & 15, n = (i >> 8) & 63, dir = (i >> 14) & 1, g = i >> 15;
        const float* ap = apow + (((size_t)dir * 32 + g) * 64 + n) * 34 + 2 * (dir == 0 ? 15 - s : s);
        const float* bb = bbar + (((size_t)dir * 32 + g) * 64 + n) * 32 + 2 * ci;
        const float vr = ap[0] * bb[0] - ap[1] * bb[1], vi = ap[0] * bb[1] + ap[1] * bb[0];
        bf16_t* d = PT + ((size_t)g * 256 + dir * 128 + n) * 256 + s * 16 + ci;
        d[0] = (bf16_t)f2bf(vr); d[64 * 256] = (bf16_t)f2bf(vi);
    }
}
__device__ __forceinline__ void row_phase(CParams& p, int l, int kind, const int G, const int bx, const int rlo = 0, const int rhi = M) {
    const int tid = pg8::opaque_tid(), lane = tid & 63, wave = tid >> 6;
    const float* modb = (const float*)(p.ws + WS_MOD);
    const bool upd = !(kind == 0 && l == 0), mkh = kind != 3;
    const int lu = (kind == 0 || kind == 3) ? (kind == 3 ? 1 : l - 1) : l;
    const int gidx = (kind == 0 || kind == 3) ? 8 : (kind == 1 ? 2 : 5), pidx = (kind == 0 || kind == 3) ? 2 : (kind == 1 ? 0 : 1);
    const float gs = kind == 2 ? 1.0f : 0.5f;
    const bf16_t* fsrc = (const bf16_t*)(p.ws + (kind == 2 ? WS_H : WS_F));
    const int hsub = kind == 0 ? 0 : kind;
    bf16_t* H = (bf16_t*)(p.ws + WS_H);
    const int nw = G * NWAVES; int per = (rhi - rlo + nw - 1) / nw; per += per & 1;
    const int r0 = rlo + (bx * NWAVES + wave) * per, r1 = (r0 + per) < rhi ? (r0 + per) : rhi;
    const bool from_in = (l == 0 && kind <= 1);
    const bf16_t* f2src = (const bf16_t*)(p.ws + WS_F2);
    int vcur = -1;
    f32x4 gg[4], pm[4], sh[4], xn[2][4]; u32x2 xnb[2][4], fn[2][4], fn2[2][4];
#define ROW_FETCH(r_) do { _Pragma("unroll") for (int q = 0; q < 2; ++q) { const int rr_ = (r_) + q; if (rr_ < r1) { \
        if (from_in) { const float* xs_ = rr_ < MCTX ? p.in[0] + (size_t)rr_ * D : p.in[1] + (size_t)(rr_ - MCTX) * D; \
            _Pragma("unroll") for (int j = 0; j < 4; ++j) xn[q][j] = __builtin_nontemporal_load((const f32x4*)(xs_ + 4 * lane + 256 * j)); } \
        else { const bf16_t* xs_ = (const bf16_t*)(p.out + (size_t)rr_ * D); \
            _Pragma("unroll") for (int j = 0; j < 4; ++j) xnb[q][j] = __builtin_nontemporal_load((const u32x2*)(xs_ + 4 * lane + 256 * j)); } \
        if (upd) { _Pragma("unroll") for (int j = 0; j < 4; ++j) { fn[q][j] = __builtin_nontemporal_load((const u32x2*)(fsrc + (size_t)rr_ * D + 4 * lane + 256 * j)); \
            if (rr_ >= MSPLIT) fn2[q][j] = __builtin_nontemporal_load((const u32x2*)(f2src + (size_t)(rr_ - MSPLIT) * D + 4 * lane + 256 * j)); } } } } } while (0)
    if (r0 < r1) ROW_FETCH(r0);
    for (int r = r0; r < r1; r += 2) {
        const int v = r < MCTX ? 0 : 1 + ((r - MCTX) >> 12);
        if (v != vcur) {
            vcur = v;
#pragma unroll
            for (int j = 0; j < 4; ++j) {
                if (upd) { const f32x4 ga = *(const f32x4*)(modb + ((size_t)lu * 9 + v) * 9216 + gidx * 1024 + 4 * lane + 256 * j), gq = *(const f32x4*)(p.in[11] + ((size_t)lu * 3 + pidx) * D + 4 * lane + 256 * j); gg[j] = ga * gq * gs; }
                if (mkh) { const float* mv = modb + ((size_t)l * 9 + v) * 9216 + hsub * 3 * 1024;
                    const f32x4 s_ = *(const f32x4*)(mv + 4 * lane + 256 * j), sc = *(const f32x4*)(mv + 1024 + 4 * lane + 256 * j), gq = *(const f32x4*)(p.in[10] + ((size_t)l * 3 + hsub) * D + 4 * lane + 256 * j);
                    pm[j] = gq * (sc + 1.0f); sh[j] = s_; }
            }
        }
        f32x4 x[2][4]; u32x2 fw[2][4], fw2[2][4];
#pragma unroll
        for (int q = 0; q < 2; ++q)
#pragma unroll
            for (int j = 0; j < 4; ++j) { x[q][j] = from_in ? xn[q][j] : (f32x4){bflo(xnb[q][j].x), bfhi(xnb[q][j].x), bflo(xnb[q][j].y), bfhi(xnb[q][j].y)}; fw[q][j] = fn[q][j]; fw2[q][j] = fn2[q][j]; }
        if (r + 2 < r1) ROW_FETCH(r + 2);
        const bool two = r + 1 < r1, hi2 = r >= MSPLIT;
        if (upd) {
            f32x4 f[2][4]; float ss[2] = {0.f, 0.f};
#pragma unroll
            for (int q = 0; q < 2; ++q)
#pragma unroll
                for (int j = 0; j < 4; ++j) { f[q][j] = (f32x4){bflo(fw[q][j].x), bfhi(fw[q][j].x), bflo(fw[q][j].y), bfhi(fw[q][j].y)}; if (hi2) f[q][j] = f[q][j] + (f32x4){bflo(fw2[q][j].x), bfhi(fw2[q][j].x), bflo(fw2[q][j].y), bfhi(fw2[q][j].y)};
                    ss[q] += f[q][j][0] * f[q][j][0] + f[q][j][1] * f[q][j][1] + f[q][j][2] * f[q][j][2] + f[q][j][3] * f[q][j][3]; }
#pragma unroll
            for (int o = 1; o < 64; o <<= 1) { ss[0] += shx(ss[0], o, lane); ss[1] += shx(ss[1], o, lane); }
#pragma unroll
            for (int q = 0; q < 2; ++q) { const float rstd = rsqrtf(ss[q] * (1.f / D) + RMS_EPS);
#pragma unroll
                for (int j = 0; j < 4; ++j) x[q][j] = x[q][j] + gg[j] * (f[q][j] * rstd); }
        }
#pragma unroll
        for (int q = 0; q < 2; ++q) { if (q == 1 && !two) break;
            if (kind == 3) {
#pragma unroll
                for (int j = 0; j < 4; ++j) __builtin_nontemporal_store(x[q][j], (f32x4*)(p.out + (size_t)(r + q) * D + 4 * lane + 256 * j));
            } else if (upd) {
#pragma unroll
                for (int j = 0; j < 4; ++j) __builtin_nontemporal_store(pack4(x[q][j]), (u32x2*)((bf16_t*)(p.out + (size_t)(r + q) * D) + 4 * lane + 256 * j));
            } }
        if (mkh) {
            float ss[2] = {0.f, 0.f};
#pragma unroll
            for (int q = 0; q < 2; ++q)
#pragma unroll
                for (int j = 0; j < 4; ++j) ss[q] += x[q][j][0] * x[q][j][0] + x[q][j][1] * x[q][j][1] + x[q][j][2] * x[q][j][2] + x[q][j][3] * x[q][j][3];
#pragma unroll
            for (int o = 1; o < 64; o <<= 1) { ss[0] += shx(ss[0], o, lane); ss[1] += shx(ss[1], o, lane); }
#pragma unroll
            for (int q = 0; q < 2; ++q) { if (q == 1 && !two) break; const float rstd = rsqrtf(ss[q] * (1.f / D) + RMS_EPS);
#pragma unroll
                for (int j = 0; j < 4; ++j) { const f32x4 h = (x[q][j] * rstd) * pm[j] + sh[j]; *(u32x2*)(H + (size_t)(r + q) * D + 4 * lane + 256 * j) = pack4(h); } }
        }
    }
#undef ROW_FETCH
}
template <int PASS> __device__ __forceinline__ void lru_pass(CParams& p, int l, LAS unsigned char* lds, const int G, const int bx, bf16_t* ydst) {
    const int tid = pg8::opaque_tid(), lane = tid & 63, wave = tid >> 6, fr = lane & 15, fq = lane >> 4;
    const int blk = bx & 7, ttstep = G >> 3;
    const bf16_t* XL = (const bf16_t*)(p.ws + WS_XL);
    LAS float* xc = (LAS float*)lds;
    LAS bf16_t* xb = (LAS bf16_t*)(lds + 16640);
    LAS float* AB = (LAS float*)(lds + 16640 + 9216);
    const int ct = tid >> 3, c0 = (tid & 7) * 8, cch = blk * 64 + c0;
    float wcv[4][8], bcv[8];
    {
        const float* bc = p.in[17] + (size_t)l * 512 + cch;
#pragma unroll
        for (int k = 0; k < 8; ++k) bcv[k] = bc[k];
#pragma unroll
        for (int j = 0; j < 4; ++j) { const float* wc = p.in[16] + ((size_t)l * 4 + j) * 512 + cch;
#pragma unroll
            for (int k = 0; k < 8; ++k) wcv[j][k] = wc[k]; }
    }
    const int dir = wave >> 2, tq = wave & 3;
    bf16x8 wfa[4][2], wfx[4][2]; float pba[4], pbx[4], psp[4];
    {
        const bf16_t* WL = (const bf16_t*)(p.ws + WS_WL) + ((size_t)(dir * 2) * 8 + blk) * 4096;
#pragma unroll
        for (int nb = 0; nb < 4; ++nb) {
#pragma unroll
            for (int kk = 0; kk < 2; ++kk) { wfa[nb][kk] = *(const bf16x8*)(WL + (16 * nb + fr) * 64 + 32 * kk + 8 * fq); wfx[nb][kk] = *(const bf16x8*)(WL + 8 * 4096 + (16 * nb + fr) * 64 + 32 * kk + 8 * fq); }
            const size_t pb = ((size_t)l * 2 + dir) * 512 + blk * 64 + 16 * nb + fr;
            pba[nb] = p.in[19][pb]; pbx[nb] = p.in[21][pb]; psp[nb] = -8.0f * 1.4426950408889634f * __logf(1.0f + __expf(-p.in[22][pb]));
        }
    }
    u32x4 xr[4]; u32x4 ylr; float cinr = 0.f;
#define LRU_FETCH(tt_) do { const int row0_ = (tt_) * 64; const int seqlen_ = row0_ < MCTX ? 256 : 4096, tp0_ = row0_ < MCTX ? (row0_ & 255) : ((row0_ - MCTX) & 4095); \
        _Pragma("unroll") for (int j = 0; j < 4; ++j) { const int tp = tp0_ + ct + j - 2; xr[j] = (u32x4){0u, 0u, 0u, 0u}; if (tp >= 0 && tp < seqlen_) xr[j] = *(const u32x4*)(XL + (size_t)(row0_ + ct + j - 2) * 512 + cch); } \
        if (PASS == 3) { ylr = *(const u32x4*)((const bf16_t*)(p.ws + WS_YL) + (size_t)(row0_ + ct) * 512 + cch); if (tid < 128) cinr = ((const float*)(p.ws + WS_CIN))[((size_t)(tid >> 6) * 640 + (tt_)) * 512 + blk * 64 + (tid & 63)]; } } while (0)
    const bool rebal = (G == 256);
    const int nown = rebal ? (bx < 64 ? 17 : 20) : (640 - (bx >> 3) + ttstep - 1) / ttstep, ntl = nown + ((rebal && bx >= 64) ? 1 : 0);
    const int ttx = ((bx & 63) >> 3) + 32 * (16 + (bx >> 6));
#define LRU_TT(q_) ((q_) < nown ? (bx >> 3) + (q_) * ttstep : ttx)
    if (ntl > 0) LRU_FETCH(LRU_TT(0));
    for (int q = 0; q < ntl; ++q) {
        const int tt = LRU_TT(q);
        {
            float a[8];
#pragma unroll
            for (int k = 0; k < 8; ++k) a[k] = bcv[k];
#pragma unroll
            for (int j = 0; j < 4; ++j) { const u32x4 w = xr[j];
                a[0] += bflo(w.x) * wcv[j][0]; a[1] += bfhi(w.x) * wcv[j][1]; a[2] += bflo(w.y) * wcv[j][2]; a[3] += bfhi(w.y) * wcv[j][3]; a[4] += bflo(w.z) * wcv[j][4]; a[5] += bfhi(w.z) * wcv[j][5]; a[6] += bflo(w.w) * wcv[j][6]; a[7] += bfhi(w.w) * wcv[j][7]; }
#pragma unroll
            for (int k = 0; k < 8; ++k) xc[ct * 65 + c0 + k] = a[k];
            u32x4 o; o.x = cvt_pk_bf16(a[0], a[1]); o.y = cvt_pk_bf16(a[2], a[3]); o.z = cvt_pk_bf16(a[4], a[5]); o.w = cvt_pk_bf16(a[6], a[7]);
            *(LAS u32x4*)(xb + ct * 72 + c0) = o;
        }
        u32x4 ylc; float cinc = 0.f; if (PASS == 3) { ylc = ylr; cinc = cinr; }
        if (q + 1 < ntl) LRU_FETCH(LRU_TT(q + 1));
        __syncthreads();
        {
            bf16x8 af[2];
#pragma unroll
            for (int kk = 0; kk < 2; ++kk) af[kk] = *(const LAS bf16x8*)(xb + (16 * tq + fr) * 72 + 32 * kk + 8 * fq);
#pragma unroll
            for (int nb = 0; nb < 4; ++nb) {
                f32x4 za = {0.f, 0.f, 0.f, 0.f}, zx = {0.f, 0.f, 0.f, 0.f};
#pragma unroll
                for (int kk = 0; kk < 2; ++kk) { za = __builtin_amdgcn_mfma_f32_16x16x32_bf16(af[kk], wfa[nb][kk], za, 0, 0, 0); zx = __builtin_amdgcn_mfma_f32_16x16x32_bf16(af[kk], wfx[nb][kk], zx, 0, 0, 0); }
                const int c = 16 * nb + fr;
#pragma unroll
                for (int j = 0; j < 4; ++j) { const int t = 16 * tq + 4 * fq + j;
                    const float r = sigm_f(za[j] + pba[nb]), ig = sigm_f(zx[j] + pbx[nb]), a = __builtin_amdgcn_exp2f(r * psp[nb]),
                        em = __builtin_fmaf(-a, a, 1.0f), b = __builtin_amdgcn_sqrtf(em) * (ig * xc[t * 65 + c]);
                    AB[(dir * 64 + t) * 64 + c] = a; AB[8192 + (dir * 64 + t) * 64 + c] = b; }
            }
        }
        __syncthreads();
        if (tid < 128) {
            const int sd = tid >> 6, c = tid & 63, ch = blk * 64 + c;
            LAS float* A = AB + sd * 4096 + c; LAS float* B = A + 8192;
            if (PASS == 1) {
                float P = 1.f, h = 0.f;
#pragma unroll 1
                for (int k0 = 0; k0 < 64; k0 += 8) { float a[8], b[8];
#pragma unroll
                    for (int k = 0; k < 8; ++k) { const int t = sd ? 63 - (k0 + k) : k0 + k; a[k] = A[t * 64]; b[k] = B[t * 64]; }
#pragma unroll
                    for (int k = 0; k < 8; ++k) { h = a[k] * h + b[k]; P *= a[k]; } }
                float* ag = (float*)(p.ws + WS_AGG) + (((size_t)sd * 640 + tt) * 512 + ch) * 2; ag[0] = P; ag[1] = h;
            } else {
                float h = cinc;
#pragma unroll 1
                for (int k0 = 0; k0 < 64; k0 += 8) { float a[8], b[8];
#pragma unroll
                    for (int k = 0; k < 8; ++k) { const int t = sd ? 63 - (k0 + k) : k0 + k; a[k] = A[t * 64]; b[k] = B[t * 64]; }
#pragma unroll
                    for (int k = 0; k < 8; ++k) { const int t = sd ? 63 - (k0 + k) : k0 + k; h = a[k] * h + b[k]; B[t * 64] = h; } }
            }
        }
        if (PASS == 3) {
            __syncthreads();
            bf16_t* yp = ydst + (size_t)(tt * 64 + ct) * 512 + cch;
            const u32x4 w = ylc; const float yl[8] = {bflo(w.x), bfhi(w.x), bflo(w.y), bfhi(w.y), bflo(w.z), bfhi(w.z), bflo(w.w), bfhi(w.w)};
            float o[8];
#pragma unroll
            for (int k = 0; k < 8; ++k) o[k] = (AB[8192 + ct * 64 + c0 + k] + AB[8192 + 4096 + ct * 64 + c0 + k]) * gelu_f(yl[k]);
            u32x4 ov; ov.x = cvt_pk_bf16(o[0], o[1]); ov.y = cvt_pk_bf16(o[2], o[3]); ov.z = cvt_pk_bf16(o[4], o[5]); ov.w = cvt_pk_bf16(o[6], o[7]);
            *(u32x4*)yp = ov;
        }
    }
#undef LRU_FETCH
#undef LRU_TT
    __syncthreads();
}
__device__ __forceinline__ void lru_carry(CParams& p, int l, const int G, const int bx) {
    const float* AGG = (const float*)(p.ws + WS_AGG); float* CIN = (float*)(p.ws + WS_CIN);
    for (int i = bx * NT + pg8::opaque_tid(); i < 40 * 2 * 512; i += G * NT) {
        const int ch = i & 511, dir = (i >> 9) & 1, seq = i >> 10;
        const bool ctx = seq < 32; const int nt = ctx ? 4 : 64, t0 = ctx ? seq * 4 : 128 + (seq - 32) * 64;
        float h = ctx ? 0.f : p.in[5][(((size_t)(seq - 32) * 2 + l) * 2 + dir) * 512 + ch];
        for (int k0 = 0; k0 < nt; k0 += 16) { f32x2 ab[16];
#pragma unroll
            for (int k = 0; k < 16; ++k) if (k0 + k < nt) { const int tt = t0 + (dir ? nt - 1 - (k0 + k) : k0 + k); ab[k] = *(const f32x2*)(AGG + 2 * (((size_t)dir * 640 + tt) * 512 + ch)); }
#pragma unroll
            for (int k = 0; k < 16; ++k) if (k0 + k < nt) { const int tt = t0 + (dir ? nt - 1 - (k0 + k) : k0 + k); CIN[((size_t)dir * 640 + tt) * 512 + ch] = h; h = ab[k][0] * h + ab[k][1]; } }
        if (ctx) p.out[OUT_LRU + (((size_t)seq * 2 + l) * 2 + dir) * 512 + ch] = h;
    }
}
__device__ __forceinline__ void attn_tile(const LAS bf16_t* Kb, const LAS bf16_t* Vb, const bf16x8 (&qf)[2][2], f32x4 (&o)[4][2], float (&mrun)[2], float (&lrun)[2], const bool masked, const int key0, const int qw, const int fr, const int fq, const int lane) {
    f32x4 s[2][4];
#pragma unroll
    for (int m = 0; m < 2; ++m)
#pragma unroll
        for (int n = 0; n < 4; ++n) s[m][n] = (f32x4){0.f, 0.f, 0.f, 0.f};
#pragma unroll
    for (int n = 0; n < 4; ++n)
#pragma unroll
        for (int kk = 0; kk < 2; ++kk) { const bf16x8 kf = *(const LAS bf16x8*)(Kb + (16 * n + fr) * 72 + 32 * kk + 8 * fq);
#pragma unroll
            for (int m = 0; m < 2; ++m) s[m][n] = __builtin_amdgcn_mfma_f32_16x16x32_bf16(kf, qf[m][kk], s[m][n], 0, 0, 0); }
    if (masked) {
#pragma unroll
        for (int m = 0; m < 2; ++m) { const int q = qw + 16 * m + fr;
#pragma unroll
            for (int n = 0; n < 4; ++n)
#pragma unroll
                for (int j = 0; j < 4; ++j) { const int dk = key0 + 16 * n + 4 * fq + j - q; if (dk > 128 || dk < -128) s[m][n][j] = -1e30f; } }
    }
    bf16x8 pf[2][2];
#pragma unroll
    for (int m = 0; m < 2; ++m) {
        float mx = s[m][0][0];
#pragma unroll
        for (int n = 0; n < 4; ++n)
#pragma unroll
            for (int j = 0; j < 4; ++j) mx = fmaxf(mx, s[m][n][j]);
        mx = fmaxf(mx, shx(mx, 16, lane)); mx = fmaxf(mx, shx(mx, 32, lane));
        const float mn = fmaxf(mrun[m], mx), al = __builtin_amdgcn_exp2f(mrun[m] - mn); mrun[m] = mn;
        float ps = 0.f;
#pragma unroll
        for (int n = 0; n < 4; ++n)
#pragma unroll
            for (int j = 0; j < 4; ++j) { const float e = __builtin_amdgcn_exp2f(s[m][n][j] - mn); s[m][n][j] = e; ps += e; }
        lrun[m] = lrun[m] * al + ps;
        if (__any(al < 1.0f)) {
#pragma unroll
            for (int db = 0; db < 4; ++db) o[db][m] = o[db][m] * al;
        }
#pragma unroll
        for (int kk = 0; kk < 2; ++kk) { const u32x4 w = pack8(s[m][2 * kk], s[m][2 * kk + 1]); pf[m][kk] = __builtin_bit_cast(bf16x8, w); }
    }
#pragma unroll
    for (int db = 0; db < 4; ++db)
#pragma unroll
        for (int kk = 0; kk < 2; ++kk) {
            const u32x2 v0 = *(const LAS u32x2*)(Vb + (16 * db + fr) * 72 + 32 * kk + 4 * fq), v1 = *(const LAS u32x2*)(Vb + (16 * db + fr) * 72 + 32 * kk + 16 + 4 * fq);
            const u32x4 vw = {v0.x, v0.y, v1.x, v1.y}; const bf16x8 vf = __builtin_bit_cast(bf16x8, vw);
#pragma unroll
            for (int m = 0; m < 2; ++m) o[db][m] = __builtin_amdgcn_mfma_f32_16x16x32_bf16(vf, pf[m][kk], o[db][m], 0, 0, 0);
        }
}
__device__ __forceinline__ void attn_unit(CParams& p, int l, int unit, LAS unsigned char* lds, bf16_t* odst) {
    const int tid = pg8::opaque_tid(), lane = tid & 63, wave = tid >> 6, fr = lane & 15, fq = lane >> 4;
    int seq, hp, qb, T, rowbase; bool lat;
    if (unit < 1024) { lat = true; seq = unit >> 7; hp = (unit >> 5) & 3; qb = unit & 31; T = 4096; rowbase = MCTX + seq * 4096; }
    else { const int u2 = unit - 1024; lat = false; seq = u2 >> 3; hp = (u2 >> 1) & 3; qb = u2 & 1; T = 256; rowbase = seq * 256; }
    const int kvh = hp >> 1, head = hp * 2 + (wave >> 2), q0 = qb * 128, qw = q0 + 32 * (wave & 3);
    int kstart, nloc;
    if (lat) { kstart = q0 - 128 < 0 ? 0 : q0 - 128; const int kend = q0 + 256 > T ? T : q0 + 256; nloc = (kend - kstart) >> 6; } else { kstart = 0; nloc = 4; }
    const int ntile = lat ? nloc + 8 : nloc;
    bf16_t* QB = (bf16_t*)(p.ws + WS_QB);
    const bf16_t* KB = (const bf16_t*)(p.ws + WS_KB); const bf16_t* VT = (const bf16_t*)(p.ws + WS_VT);
    const bf16_t* CK = (const bf16_t*)(p.ws + WS_CK); const bf16_t* CVT = (const bf16_t*)(p.ws + WS_CVT);
    LAS bf16_t* Kl = (LAS bf16_t*)lds;
    LAS bf16_t* Vl = (LAS bf16_t*)(lds + 18432);
    const int lr = tid >> 3, lc = (tid & 7) * 8;
#define ATT_LOAD(tix) do { if ((tix) < nloc) { const int key0 = kstart + 64 * (tix); \
            kreg = *(const u32x4*)(KB + (size_t)(rowbase + key0 + lr) * 128 + kvh * 64 + lc); vreg = *(const u32x4*)(VT + (size_t)(kvh * 64 + lr) * M + rowbase + key0 + lc); } \
        else { const int c_ = (tix) - nloc; kreg = *(const u32x4*)(CK + (((size_t)seq * 2 + kvh) * 512 + 64 * c_ + lr) * 64 + lc); vreg = *(const u32x4*)(CVT + (((size_t)seq * 2 + kvh) * 64 + lr) * 512 + 64 * c_ + lc); } } while (0)
#define ATT_STORE(buf) do { *(LAS u32x4*)(Kl + (buf) * 4608 + lr * 72 + lc) = kreg; *(LAS u32x4*)(Vl + (buf) * 4608 + lr * 72 + lc) = vreg; } while (0)
    u32x4 kreg, vreg, kreg2, vreg2;
#define ATT_LOAD2(tix) do { if ((tix) < nloc) { const int key0 = kstart + 64 * (tix); \
            kreg2 = *(const u32x4*)(KB + (size_t)(rowbase + key0 + lr) * 128 + kvh * 64 + lc); vreg2 = *(const u32x4*)(VT + (size_t)(kvh * 64 + lr) * M + rowbase + key0 + lc); } \
        else { const int c_ = (tix) - nloc; kreg2 = *(const u32x4*)(CK + (((size_t)seq * 2 + kvh) * 512 + 64 * c_ + lr) * 64 + lc); vreg2 = *(const u32x4*)(CVT + (((size_t)seq * 2 + kvh) * 64 + lr) * 512 + 64 * c_ + lc); } } while (0)
#define ATT_STORE2(buf) do { *(LAS u32x4*)(Kl + (buf) * 4608 + lr * 72 + lc) = kreg2; *(LAS u32x4*)(Vl + (buf) * 4608 + lr * 72 + lc) = vreg2; } while (0)
    ATT_LOAD(0);
    if (1 < ntile) ATT_LOAD2(1);
    bf16x8 qf[2][2];
#pragma unroll
    for (int m = 0; m < 2; ++m)
#pragma unroll
        for (int kk = 0; kk < 2; ++kk) qf[m][kk] = *(const bf16x8*)(QB + (size_t)(rowbase + qw + 16 * m + fr) * 512 + head * 64 + 32 * kk + 8 * fq);
    const float sink2 = p.in[32][l * 8 + head] * LOG2E;
    float mrun[2] = {sink2, sink2}, lrun[2] = {fq == 0 ? 1.f : 0.f, fq == 0 ? 1.f : 0.f};
    f32x4 o[4][2];
#pragma unroll
    for (int db = 0; db < 4; ++db)
#pragma unroll
        for (int m = 0; m < 2; ++m) o[db][m] = (f32x4){0.f, 0.f, 0.f, 0.f};
    ATT_STORE(0);
    __syncthreads();
    for (int tix = 0; tix < ntile; tix += 2) {
        if (tix + 2 < ntile) ATT_LOAD(tix + 2);
        { const bool loc_ = lat && tix < nloc; const int k0_ = kstart + 64 * tix;
          if (!(loc_ && (k0_ > qw + 159 || k0_ + 63 < qw - 128))) attn_tile(Kl, Vl, qf, o, mrun, lrun, loc_, k0_, qw, fr, fq, lane); }
        if (tix + 1 < ntile) ATT_STORE2(1);
        __syncthreads();
        if (tix + 1 < ntile) {
            if (tix + 3 < ntile) ATT_LOAD2(tix + 3);
            { const bool loc_ = lat && tix + 1 < nloc; const int k0_ = kstart + 64 * (tix + 1);
              if (!(loc_ && (k0_ > qw + 159 || k0_ + 63 < qw - 128))) attn_tile(Kl + 4608, Vl + 4608, qf, o, mrun, lrun, loc_, k0_, qw, fr, fq, lane); }
            if (tix + 2 < ntile) ATT_STORE(0);
            __syncthreads();
        }
    }
#pragma unroll
    for (int m = 0; m < 2; ++m) {
        float lt = lrun[m]; lt += shx(lt, 16, lane); lt += shx(lt, 32, lane);
        const float inv = 1.0f / lt;
        bf16_t* op = odst + (size_t)(rowbase + qw + 16 * m + fr) * 512 + head * 64 + 4 * fq;
#pragma unroll
        for (int db = 0; db < 4; ++db) *(u32x2*)(op + 16 * db) = pack4(o[db][m] * inv);
    }
#undef ATT_LOAD
#undef ATT_STORE
#undef ATT_LOAD2
#undef ATT_STORE2
}
struct OneUnit { int pm, pn;
    __device__ bool next(int i, Unit& u) const { if (i) return false; u.pm = pm; u.pn = pn; return true; }
    __device__ __forceinline__ void a_ready(const Unit&) const {}
    __device__ __forceinline__ void done(const Unit&) const {} };
struct PanelOrder { int pm;
    __device__ bool next(int i, Unit& u) const { if (i >= 4) return false; u.pm = pm; u.pn = i; return true; }
    __device__ __forceinline__ void a_ready(const Unit&) const {}
    __device__ __forceinline__ void done(const Unit&) const {} };
__device__ __forceinline__ void gemm_n1024_full(LAS unsigned char* lds, const bf16_t* A, const bf16_t* Bt, const int K, bf16_t* O, const int Gs, const int cs) {
    pg8::Gemm g{A, Bt, MSPLIT, D, K, K, K}; pg8::Order S; S.init(MSPLIT, D, Gs, cs); EpiPlain E{O, D}; pg8::gemm_phase<EpiPlain, pg8::Order, true, true>(lds, g, S, E);
}
__device__ __forceinline__ void gemm_n1024_halves(LAS unsigned char* lds, const bf16_t* A, const bf16_t* Bt, const int K, bf16_t* O, bf16_t* O2, const int G, const int bx) {
    for (int u = bx; u < 256; u += G) { const int t = u >> 1, kh = u & 1, Kh = K >> 1;
        pg8::Gemm g{A + kh * Kh, Bt + kh * Kh, M, D, Kh, K, K}; OneUnit S{128 + (t >> 2), t & 3}; EpiPlain E{kh ? O2 - (size_t)MSPLIT * D : O, D};
        pg8::gemm_phase<EpiPlain, OneUnit, true, true>(lds, g, S, E); }
}
__device__ __forceinline__ void gemm_n1024_splitk(LAS unsigned char* lds, const bf16_t* A, const bf16_t* Bt, const int K, bf16_t* O, bf16_t* O2, const int G, const int bx) {
    gemm_n1024_full(lds, A, Bt, K, O, G, bx); gemm_n1024_halves(lds, A, Bt, K, O, O2, G, bx);
}
template <class Sched> __device__ __forceinline__ void merge_chain(LAS unsigned char* lds, unsigned char* ws, const bf16_t* H, pg8::u32x4* scr, const Sched& S) {
    const bf16_t* WIN = (const bf16_t*)(ws + WS_WIN); bf16_t* MG = (bf16_t*)(ws + WS_MERGED);
    { pg8::Gemm g{H, WIN + (size_t)2304 * D, M, D, D, D, D}; EpiMerge<0> E{scr, MG}; pg8::gemm_phase<EpiMerge<0>, Sched, true, true>(lds, g, S, E); }
    { pg8::Gemm g{(const bf16_t*)(ws + WS_YL), (const bf16_t*)(ws + WS_WOL), M, D, 512, 512, 512}; EpiMerge<1> E{scr, MG}; pg8::gemm_phase<EpiMerge<1>, Sched, true, true>(lds, g, S, E); }
    { pg8::Gemm g{H, WIN + (size_t)3328 * D, M, D, D, D, D}; EpiMerge<0> E{scr, MG}; pg8::gemm_phase<EpiMerge<0>, Sched, true, true>(lds, g, S, E); }
    { pg8::Gemm g{(const bf16_t*)(ws + WS_S5Y), (const bf16_t*)(ws + WS_WGLU), M, D, 512, 512, 512}; EpiMerge<2> E{scr, MG}; pg8::gemm_phase<EpiMerge<2>, Sched, true, true>(lds, g, S, E); }
    { pg8::Gemm g{(const bf16_t*)(ws + WS_S5Y), (const bf16_t*)(ws + WS_WGLU) + (size_t)1024 * 512, M, D, 512, 512, 512}; EpiMerge<3> E{scr, MG}; pg8::gemm_phase<EpiMerge<3>, Sched, true, true>(lds, g, S, E); }
    { pg8::Gemm g{H, WIN + (size_t)4352 * D, M, D, D, D, D}; EpiMerge<0> E{scr, MG}; pg8::gemm_phase<EpiMerge<0>, Sched, true, true>(lds, g, S, E); }
    { pg8::Gemm g{(const bf16_t*)(ws + WS_QB), (const bf16_t*)(ws + WS_WOA), M, D, 512, 512, 512}; EpiMerge<4> E{scr, MG}; pg8::gemm_phase<EpiMerge<4>, Sched, true, true>(lds, g, S, E); }
}
constexpr int NPHASE = 29;
#ifndef ONLY_K
#define ONLY_K -1
#endif
#define EN(n) (ONLY_K < 0 || ONLY_K == (n) || ONLY_K / 10 == (n))
#define SUB(j) (ONLY_K < 20 || ONLY_K % 10 == (j))
#ifndef MK_SPLIT
#define MK_SPLIT 0
#endif
constexpr int REPS[14] = {1, 1, 1, 1, 1, 1, 1, 1, 1, 1, 1, 1, 1, 1};
constexpr int EXTRA_SYNCS = 0;
constexpr bool PROBE_ATT = false, PROBE_MIXB = false;
#define PH_ON(q) (ph_lo <= (q) && (q) < ph_hi)
template <int l> __device__ __forceinline__ void run_layer(CParams* kp, const int ph_lo, const int ph_hi, LAS unsigned char* lds, cg::grid_group& grid, const XcdBarrier& xbar) {
    if (PH_ON(14 * l + 0)) {
      _Pragma("unroll") for (int rep = 0; rep < REPS[0]; ++rep) { if (rep) xcd_barrier(xbar);
        { CParams* kq = kp; asm volatile("" : "+s"(kq)); CParams& p = *kq; unsigned char* ws = p.ws; (void)ws;
          int G = gridDim.x, bx = blockIdx.x; asm volatile("" : "+s"(G), "+s"(bx));
          bf16_t* H = (bf16_t*)(ws + WS_H); bf16_t* F = (bf16_t*)(ws + WS_F); (void)H; (void)F;
          prep_phase(p, l, lds, G, bx);
        } }
        if (14 * l + 0 + 1 < ph_hi) { if (l == 0 && ph_hi < 0) grid.sync();
                                      xcd_barrier(xbar); }
    }
    if (PH_ON(14 * l + 1)) {
      _Pragma("unroll") for (int rep = 0; rep < REPS[1]; ++rep) { if (rep) xcd_barrier(xbar);
        { CParams* kq = kp; asm volatile("" : "+s"(kq)); CParams& p = *kq; unsigned char* ws = p.ws; (void)ws;
          int G = gridDim.x, bx = blockIdx.x; asm volatile("" : "+s"(G), "+s"(bx));
          bf16_t* H = (bf16_t*)(ws + WS_H); bf16_t* F = (bf16_t*)(ws + WS_F); (void)H; (void)F;
          prep2_phase(p, l, G, bx); row_phase(p, l, 0, G, bx);
        } }
        if (14 * l + 1 + 1 < ph_hi) xcd_barrier(xbar);
    }
    if (PH_ON(14 * l + 2)) {
      _Pragma("unroll") for (int rep = 0; rep < REPS[2]; ++rep) { if (rep) xcd_barrier(xbar);
        { CParams* kq = kp; asm volatile("" : "+s"(kq)); CParams& p = *kq; unsigned char* ws = p.ws; (void)ws;
          int G = gridDim.x, bx = blockIdx.x; asm volatile("" : "+s"(G), "+s"(bx));
          bf16_t* H = (bf16_t*)(ws + WS_H); bf16_t* F = (bf16_t*)(ws + WS_F); (void)H; (void)F;
          {
            pg8::Gemm g{H, (const bf16_t*)(ws + WS_WGU0), M, 2 * FF, D, D, D}; pg8::Order S; S.init(M, 2 * FF, G, bx);
            EpiSwiGLU E{(bf16_t*)(ws + WS_ACT)};
            pg8::gemm_phase<EpiSwiGLU, pg8::Order, true, true>(lds, g, S, E);
        }
        } }
        if (14 * l + 2 + 1 < ph_hi) xcd_barrier(xbar);
    }
    if (PH_ON(14 * l + 3)) {
      _Pragma("unroll") for (int rep = 0; rep < REPS[3]; ++rep) { if (rep) xcd_barrier(xbar);
        { CParams* kq = kp; asm volatile("" : "+s"(kq)); CParams& p = *kq; unsigned char* ws = p.ws; (void)ws;
          int G = gridDim.x, bx = blockIdx.x; asm volatile("" : "+s"(G), "+s"(bx));
          bf16_t* H = (bf16_t*)(ws + WS_H); bf16_t* F = (bf16_t*)(ws + WS_F); (void)H; (void)F;
          {
            gemm_n1024_splitk(lds, (const bf16_t*)(ws + WS_ACT), (const bf16_t*)(ws + WS_WD0), FF, F, (bf16_t*)(ws + WS_F2), G, bx);
        }
        } }
        if (14 * l + 3 + 1 < ph_hi) xcd_barrier(xbar);
    }
    if (PH_ON(14 * l + 4)) {
      _Pragma("unroll") for (int rep = 0; rep < REPS[4]; ++rep) { if (rep) xcd_barrier(xbar);
        { CParams* kq = kp; asm volatile("" : "+s"(kq)); CParams& p = *kq; unsigned char* ws = p.ws; (void)ws;
          int G = gridDim.x, bx = blockIdx.x; asm volatile("" : "+s"(G), "+s"(bx));
          bf16_t* H = (bf16_t*)(ws + WS_H); bf16_t* F = (bf16_t*)(ws + WS_F); (void)H; (void)F;
          row_phase(p, l, 1, G, bx);
        } }
        if (14 * l + 4 + 1 < ph_hi) xcd_barrier(xbar);
    }
    if (PH_ON(14 * l + 5)) {
      _Pragma("unroll") for (int rep = 0; rep < REPS[5]; ++rep) { if (rep) xcd_barrier(xbar);
        { CParams* kq = kp; asm volatile("" : "+s"(kq)); CParams& p = *kq; unsigned char* ws = p.ws; (void)ws;
          int G = gridDim.x, bx = blockIdx.x; asm volatile("" : "+s"(G), "+s"(bx));
          bf16_t* H = (bf16_t*)(ws + WS_H); bf16_t* F = (bf16_t*)(ws + WS_F); (void)H; (void)F;
          {
            pg8::Gemm g{H, (const bf16_t*)(ws + WS_WIN), M, NIN, D, D, D}; pg8::Order S; S.init(M, NIN, G, bx);
            EpiIn E{(bf16_t*)(ws + WS_QB), (bf16_t*)(ws + WS_KB), (bf16_t*)(ws + WS_VT), (bf16_t*)(ws + WS_XL), (bf16_t*)(ws + WS_YL), (bf16_t*)(ws + WS_UH), p.out, (const float*)(ws + WS_ROPE), l};
            pg8::gemm_phase<EpiIn, pg8::Order, true, true>(lds, g, S, E);
        }
        } }
        if (14 * l + 5 + 1 < ph_hi) xcd_barrier(xbar);
    }
    if (PH_ON(14 * l + 6)) {
      _Pragma("unroll") for (int rep = 0; rep < REPS[6]; ++rep) { if (rep) xcd_barrier(xbar);
        { CParams* kq = kp; asm volatile("" : "+s"(kq)); CParams& p = *kq; unsigned char* ws = p.ws; (void)ws;
          int G = gridDim.x, bx = blockIdx.x; asm volatile("" : "+s"(G), "+s"(bx));
          bf16_t* H = (bf16_t*)(ws + WS_H); bf16_t* F = (bf16_t*)(ws + WS_F); (void)H; (void)F;
          {
            if (SUB(0)) for (int r = 0; r < 2; ++r) {
                pg8::Gemm g{(const bf16_t*)(ws + WS_UH), (const bf16_t*)(ws + WS_PT), 32 * NCHUNK, 256, 256, 512, 256}; pg8::Order S; S.init(32 * NCHUNK, 256, G, bx, r, 1, 10);
                EpiS5State E{(bf16_t*)(ws + WS_UH), (const float*)(ws + WS_APOW), p.in[6], p.out, l};
                pg8::gemm_phase<EpiS5State, pg8::Order, false, true>(lds, g, S, E);
                __syncthreads();
            }
            if (SUB(1)) lru_pass<1>(p, l, lds, G, bx, nullptr);
        }
        } }
        if (14 * l + 6 + 1 < ph_hi) xcd_barrier(xbar);
    }
    if (PH_ON(14 * l + 7)) {
      _Pragma("unroll") for (int rep = 0; rep < REPS[7]; ++rep) { if (rep) xcd_barrier(xbar);
        { CParams* kq = kp; asm volatile("" : "+s"(kq)); CParams& p = *kq; unsigned char* ws = p.ws; (void)ws;
          int G = gridDim.x, bx = blockIdx.x; asm volatile("" : "+s"(G), "+s"(bx));
          bf16_t* H = (bf16_t*)(ws + WS_H); bf16_t* F = (bf16_t*)(ws + WS_F); (void)H; (void)F;
          {
            lru_carry(p, l, G, bx);
            if (PROBE_ATT) { for (int u = bx; u < 1280; u += G) attn_unit(p, l, u, lds, (bf16_t*)(ws + WS_S5Y)); }
            for (int u = bx; u < 1280; u += G) attn_unit(p, l, u, lds, (bf16_t*)(ws + WS_QB));
        }
        } }
        if (14 * l + 7 + 1 < ph_hi) xcd_barrier(xbar);
    }
    if (PH_ON(14 * l + 8)) {
      _Pragma("unroll") for (int rep = 0; rep < REPS[8]; ++rep) { if (rep) xcd_barrier(xbar);
        { CParams* kq = kp; asm volatile("" : "+s"(kq)); CParams& p = *kq; unsigned char* ws = p.ws; (void)ws;
          int G = gridDim.x, bx = blockIdx.x; asm volatile("" : "+s"(G), "+s"(bx));
          bf16_t* H = (bf16_t*)(ws + WS_H); bf16_t* F = (bf16_t*)(ws + WS_F); (void)H; (void)F;
          {
            if (PROBE_MIXB) { lru_pass<3>(p, l, lds, G, bx, (bf16_t*)(ws + WS_F + 40 * MiB)); }
            lru_pass<3>(p, l, lds, G, bx, (bf16_t*)(ws + WS_YL));
            if (SUB(0)) {
            pg8::Gemm g{(const bf16_t*)(ws + WS_UH), (const bf16_t*)(ws + WS_TT), 32 * NCHUNK, 256, 512, 512, 512}; pg8::Order S; S.init(32 * NCHUNK, 256, G, bx, 0, 1 << 30, 10);
            EpiS5Out E{(const bf16_t*)(ws + WS_UH), (bf16_t*)(ws + WS_S5Y), p.in[30] + (size_t)l * 512};
            pg8::gemm_phase<EpiS5Out, pg8::Order, true, true>(lds, g, S, E); }
        }
        } }
        if (14 * l + 8 + 1 < ph_hi) xcd_barrier(xbar);
    }
    if (PH_ON(14 * l + 9)) {
      _Pragma("unroll") for (int rep = 0; rep < REPS[9]; ++rep) { if (rep) xcd_barrier(xbar);
        { CParams* kq = kp; asm volatile("" : "+s"(kq)); CParams& p = *kq; unsigned char* ws = p.ws; (void)ws;
          int G = gridDim.x, bx = blockIdx.x; asm volatile("" : "+s"(G), "+s"(bx));
          bf16_t* H = (bf16_t*)(ws + WS_H); bf16_t* F = (bf16_t*)(ws + WS_F); (void)H; (void)F;
          {
            pg8::u32x4* scr = (pg8::u32x4*)(ws + WS_SCR) + (size_t)bx * 16384;
            const int nr = (G == 256) ? 2 : 3, mrows = (G == 256) ? MSPLIT : M;
            for (int r = 0; r < nr; ++r) { pg8::Order S; S.init(mrows, D, G, bx, r, 1); merge_chain<pg8::Order>(lds, ws, H, scr, S); }
          }
        } }
        if (14 * l + 9 + 1 < ph_hi) xcd_barrier(xbar);
    }
    if (PH_ON(14 * l + 10)) {
      _Pragma("unroll") for (int rep = 0; rep < REPS[10]; ++rep) { if (rep) xcd_barrier(xbar);
        { CParams* kq = kp; asm volatile("" : "+s"(kq)); CParams& p = *kq; unsigned char* ws = p.ws; (void)ws;
          int G = gridDim.x, bx = blockIdx.x; asm volatile("" : "+s"(G), "+s"(bx));
          bf16_t* H = (bf16_t*)(ws + WS_H); bf16_t* F = (bf16_t*)(ws + WS_F); (void)H; (void)F;
          {
            const bf16_t* MGc = (const bf16_t*)(ws + WS_MERGED); const bf16_t* WO = (const bf16_t*)(ws + WS_WOUT);
            if (G == 256) {
                if (bx < 128) { pg8::u32x4* scr = (pg8::u32x4*)(ws + WS_SCR) + (size_t)bx * 16384; OneUnit S{128 + (bx >> 2), bx & 3}; merge_chain<OneUnit>(lds, ws, H, scr, S); }
                else {
                    pg8::Gemm g{MGc, WO, MSPLIT, D, D, D, D}; PanelOrder S{bx - 128}; EpiPlain E{H, D}; pg8::gemm_phase<EpiPlain, PanelOrder, true, true>(lds, g, S, E);
                    asm volatile("s_waitcnt vmcnt(0)" ::: "memory"); __syncthreads();
                    row_phase(p, l, 2, 1, 0, (bx - 128) * 256, (bx - 128) * 256 + 256);
                }
                xcd_barrier(xbar);
                gemm_n1024_halves(lds, MGc, WO, D, H, (bf16_t*)(ws + WS_F2), G, bx);
            } else gemm_n1024_splitk(lds, MGc, WO, D, H, (bf16_t*)(ws + WS_F2), G, bx);
        }
        } }
        if (14 * l + 10 + 1 < ph_hi) xcd_barrier(xbar);
    }
    if (PH_ON(14 * l + 11)) {
      _Pragma("unroll") for (int rep = 0; rep < REPS[11]; ++rep) { if (rep) xcd_barrier(xbar);
        { CParams* kq = kp; asm volatile("" : "+s"(kq)); CParams& p = *kq; unsigned char* ws = p.ws; (void)ws;
          int G = gridDim.x, bx = blockIdx.x; asm volatile("" : "+s"(G), "+s"(bx));
          bf16_t* H = (bf16_t*)(ws + WS_H); bf16_t* F = (bf16_t*)(ws + WS_F); (void)H; (void)F;
          if (G == 256) row_phase(p, l, 2, G, bx, MSPLIT, M); else row_phase(p, l, 2, G, bx);
        } }
        if (14 * l + 11 + 1 < ph_hi) xcd_barrier(xbar);
    }
    if (PH_ON(14 * l + 12)) {
      _Pragma("unroll") for (int rep = 0; rep < REPS[12]; ++rep) { if (rep) xcd_barrier(xbar);
        { CParams* kq = kp; asm volatile("" : "+s"(kq)); CParams& p = *kq; unsigned char* ws = p.ws; (void)ws;
          int G = gridDim.x, bx = blockIdx.x; asm volatile("" : "+s"(G), "+s"(bx));
          bf16_t* H = (bf16_t*)(ws + WS_H); bf16_t* F = (bf16_t*)(ws + WS_F); (void)H; (void)F;
          {
            pg8::Gemm g{H, (const bf16_t*)(ws + WS_WGU1), M, 2 * FF, D, D, D}; pg8::Order S; S.init(M, 2 * FF, G, bx);
            EpiSwiGLU E{(bf16_t*)(ws + WS_ACT)};
            pg8::gemm_phase<EpiSwiGLU, pg8::Order, true, true>(lds, g, S, E);
        }
        } }
        if (14 * l + 12 + 1 < ph_hi) xcd_barrier(xbar);
    }
    if (PH_ON(14 * l + 13)) {
      _Pragma("unroll") for (int rep = 0; rep < REPS[13]; ++rep) { if (rep) xcd_barrier(xbar);
        { CParams* kq = kp; asm volatile("" : "+s"(kq)); CParams& p = *kq; unsigned char* ws = p.ws; (void)ws;
          int G = gridDim.x, bx = blockIdx.x; asm volatile("" : "+s"(G), "+s"(bx));
          bf16_t* H = (bf16_t*)(ws + WS_H); bf16_t* F = (bf16_t*)(ws + WS_F); (void)H; (void)F;
          {
            gemm_n1024_splitk(lds, (const bf16_t*)(ws + WS_ACT), (const bf16_t*)(ws + WS_WD1), FF, F, (bf16_t*)(ws + WS_F2), G, bx);
        }
        } }
        if (14 * l + 13 + 1 < ph_hi) xcd_barrier(xbar);
    }
}
__global__ void __launch_bounds__(NT, 2) fwd_kernel(Params p_unused) {
    extern __shared__ __attribute__((aligned(16))) unsigned char lds_raw[];
    LAS unsigned char* lds = (LAS unsigned char*)lds_raw;
    cg::grid_group grid = cg::this_grid();
    CParams* kp = (CParams*)__builtin_amdgcn_kernarg_segment_ptr();
    const int ph_lo = kp->ph_lo, ph_hi = kp->ph_hi;
    volatile LAS unsigned* misc = (volatile LAS unsigned*)(lds + MISC_OFF);
    if (threadIdx.x < 16) misc[threadIdx.x] = 0u;
    __syncthreads();
    XcdBarrier xbar; xbar.bar = (unsigned*)kp->ws + 1024; xbar.x = 0; xbar.st = nullptr;
    if (ph_hi - ph_lo > 1) xbar = xcd_barrier_post((unsigned*)kp->ws + 1024, misc + 8);
    run_layer<0>(kp, ph_lo, ph_hi, lds, grid, xbar);
    run_layer<1>(kp, ph_lo, ph_hi, lds, grid, xbar);
    for (int e = 0; e < EXTRA_SYNCS; ++e) xcd_barrier(xbar);
    if (PH_ON(28)) { CParams* kq = kp; asm volatile("" : "+s"(kq)); CParams& p = *kq; int G = gridDim.x, bx = blockIdx.x; asm volatile("" : "+s"(G), "+s"(bx)); row_phase(p, 1, 3, G, bx); }
}

extern "C" void kernel_launch(void* const* d_in, const int* in_sizes, int n_in, void* d_out, int out_size, void* d_ws, size_t ws_size, hipStream_t stream) {
    static int grid = 0;
    if (grid == 0) {
        if (n_in != 36 || ws_size < WS_END) { fprintf(stderr, "kernel_launch: n_in %d ws %zu (need %zu)\n", n_in, ws_size, (size_t)WS_END); grid = -1; return; }
        int dev = 0, cus = 0, per_cu = 0;
        hipGetDevice(&dev); hipDeviceGetAttribute(&cus, hipDeviceAttributeMultiprocessorCount, dev);
        if (hipFuncSetAttribute((const void*)fwd_kernel, hipFuncAttributeMaxDynamicSharedMemorySize, LDS_BYTES) != hipSuccess) { fprintf(stderr, "kernel_launch: hipFuncSetAttribute failed\n"); grid = -1; return; }
        hipOccupancyMaxActiveBlocksPerMultiprocessor(&per_cu, (const void*)fwd_kernel, NT, LDS_BYTES);
        (void)hipGetLastError();
        if (per_cu < 1) per_cu = 1;
        grid = cus * 1;
    }
    if (grid < 0) return;
    if (hipMemsetAsync(d_ws, 0, 65536, stream) != hipSuccess) { fprintf(stderr, "kernel_launch: memset failed\n"); return; }
    Params p{};
    for (int i = 0; i < 36; ++i) p.in[i] = (const float*)d_in[i];
    p.out = (float*)d_out; p.ws = (unsigned char*)d_ws;
#if MK_SPLIT
    for (int ph = 0; ph < NPHASE; ++ph) { p.ph_lo = ph; p.ph_hi = ph + 1; void* args[] = {&p};
        hipError_t e = hipLaunchCooperativeKernel((const void*)fwd_kernel, dim3(grid), dim3(NT), args, LDS_BYTES, stream);
        if (e != hipSuccess) { fprintf(stderr, "launch %d failed: %s\n", ph, hipGetErrorString(e)); break; } }
#else
    p.ph_lo = 0; p.ph_hi = NPHASE; void* args[] = {&p};
    hipError_t e = hipLaunchCooperativeKernel((const void*)fwd_kernel, dim3(grid), dim3(NT), args, LDS_BYTES, stream);
    if (e != hipSuccess) fprintf(stderr, "cooperative launch failed: %s (grid %d)\n", hipGetErrorString(e), grid);
#endif
}
```

```cpp
#include <hip/hip_runtime.h>
#include <hip/hip_cooperative_groups.h>
#include <cstdio>
#include <cstdint>
namespace cg = cooperative_groups;
namespace pg8 {
#define PG8_LAS __attribute__((address_space(3)))
typedef unsigned short bf16_t;
typedef short bf16x8 __attribute__((ext_vector_type(8)));
typedef float f32x4 __attribute__((ext_vector_type(4)));
typedef unsigned u32x4 __attribute__((ext_vector_type(4)));
typedef unsigned u32x2 __attribute__((ext_vector_type(2)));
constexpr int BM = 256, BK = 64, HALF = 128, HTB = HALF * BK * 2, STAGE_BYTES = 8 * HTB, NXCD = 8, WGM = 8;
__host__ __device__ __forceinline__ int lds_byte(int r, int c) { const int st = (r >> 4) * 2 + (c >> 5), rr = r & 15, cc = c & 31, ob = rr * 64 + cc * 2; return st * 1024 + (ob ^ (((ob >> 9) & 1) << 5)); }
__host__ __device__ __forceinline__ void stage_rc(int b, int& R, int& C) { const int st = b / 1024, sb = b % 1024, swz = sb ^ (((sb >> 9) & 1) << 5); R = (st >> 1) * 16 + swz / 64; C = (st & 1) * 32 + (swz % 64) / 2; }
__host__ __device__ __forceinline__ int perm32(int rho) { const int n = rho >> 4, i = rho & 15; return 8 * (i >> 2) + 4 * n + (i & 3); }
__device__ __forceinline__ int opaque_tid() { int t = threadIdx.x; asm volatile("" : "+v"(t)); return t; }
struct Unit { int pm, pn; };
struct Gemm { const bf16_t* A; const bf16_t* Bt; int M, N, K, lda, ldb; };
struct Order {
    int nM, nN, nwg, G, c, i0, imax, batched;
    __device__ void init(int M, int N, int G_, int c_, int i0_ = 0, int imax_ = 1 << 30, int batched_ = 0) { nM = M / BM; nN = N / BM; nwg = batched_ ? nM : nM * nN; G = G_; c = c_; i0 = i0_; imax = imax_; batched = batched_; }
    __device__ bool next(int i, Unit& u) const {
        if (i >= imax) return false;
        const long L = (long)(i0 + i) * G + c; if (L >= nwg) return false;
        if (batched) { u.pm = (int)L; u.pn = (int)L / batched; return true; }
        int wgid = (int)L; { const int q = nwg / NXCD, r = nwg % NXCD, xcd = wgid % NXCD, off = wgid / NXCD; wgid = (xcd < r ? xcd * (q + 1) : r * (q + 1) + (xcd - r) * q) + off; }
        const int nig = WGM * nN, gid = wgid / nig, fm = gid * WGM, gsz = (nM - fm) < WGM ? (nM - fm) : WGM;
        u.pm = fm + ((wgid % nig) % gsz); u.pn = (wgid % nig) / gsz; return true;
    }
    __device__ __forceinline__ void a_ready(const Unit&) const {}
    __device__ __forceinline__ void done(const Unit&) const {}
};
__device__ __forceinline__ unsigned cvt_pk_bf16(float lo, float hi) { unsigned r; asm volatile("v_cvt_pk_bf16_f32 %0, %1, %2" : "=v"(r) : "v"(lo), "v"(hi)); return r; }
template <class Epi, class Sched, bool ALIGN_EPI = false, bool SP2 = false>
__device__ __forceinline__ void gemm_phase(PG8_LAS unsigned char* lds, const Gemm g, const Sched& S, const Epi& E) {
    const int tid = pg8::opaque_tid(), wid = __builtin_amdgcn_readfirstlane(tid >> 6), lane = tid & 63, wr = wid >> 2, wc = wid & 3, fr = lane & 15, fq = lane >> 4;
    const int K = g.K, nt = K / BK;
    unsigned voffA[2], voffB[2];
#pragma unroll
    for (int i = 0; i < 2; ++i) { int R, C; stage_rc(tid * 16 + i * 8192, R, C); const int Rb = Epi::PERM ? ((R & ~31) + perm32(R & 31)) : R;
        voffA[i] = (unsigned)(R * g.lda + C) * 2u; voffB[i] = (unsigned)(Rb * g.ldb + C) * 2u; }
    const size_t kstep = (size_t)(BK * 2);
    const size_t hstepA = (size_t)HALF * g.lda * 2, hstepB = (size_t)HALF * g.ldb * 2;
    const size_t tstepA = 2 * hstepA, tstepB = 2 * hstepB;
    const unsigned ldsw = (unsigned)wid * 1024u;
    const int aoff = lds_byte(wr * 64 + fr, fq * 8), boff = lds_byte(wc * 32 + fr, fq * 8);
#define PG8_SA(b, h) (((b) * 2 + (h)) * HTB)
#define PG8_SB(b, h) ((4 + (b) * 2 + (h)) * HTB)
#define PG8_STAGE(bufoff, gbase, voff) do { _Pragma("unroll") for (int _i = 0; _i < 2; ++_i) \
        __builtin_amdgcn_global_load_lds((const unsigned*)((const char*)(gbase) + (voff)[_i]), (PG8_LAS unsigned*)(lds + (bufoff) + ldsw + _i * 8192), 16, 0, 0); } while (0)
#define PG8_LDA(dst, b, h) do { _Pragma("unroll") for (int m = 0; m < 4; ++m) _Pragma("unroll") for (int k = 0; k < 2; ++k) dst[m][k] = *(const PG8_LAS bf16x8*)(lds + PG8_SA(b, h) + aoff + m * 2048 + k * 1024); } while (0)
#define PG8_LDB(dst, b, h) do { _Pragma("unroll") for (int n = 0; n < 2; ++n) _Pragma("unroll") for (int k = 0; k < 2; ++k) dst[n][k] = *(const PG8_LAS bf16x8*)(lds + PG8_SB(b, h) + boff + n * 2048 + k * 1024); } while (0)
#define PG8_MMA(ai, bj, At, Bt) do { __builtin_amdgcn_s_setprio(1); _Pragma("unroll") for (int m = 0; m < 4; ++m) _Pragma("unroll") for (int n = 0; n < 2; ++n) _Pragma("unroll") for (int k = 0; k < 2; ++k) \
        acc[ai][bj][m][n] = __builtin_amdgcn_mfma_f32_16x16x32_bf16(Bt[n][k], At[m][k], acc[ai][bj][m][n], 0, 0, 0); __builtin_amdgcn_s_setprio(0); } while (0)
#define PG8_WAIT_V(n) asm volatile("s_waitcnt vmcnt(" #n ")" ::: "memory")
#define PG8_WAIT_L(n) asm volatile("s_waitcnt lgkmcnt(" #n ")" ::: "memory")
#define PG8_BAR __builtin_amdgcn_s_barrier()
#define PG8_SCHED __builtin_amdgcn_sched_barrier(0)
    Unit cur, nxt; int ui = 0;
    if (!S.next(0, cur)) return;
    f32x4 acc[2][2][4][2];
#pragma unroll
    for (int a = 0; a < 2; ++a)
#pragma unroll
        for (int b = 0; b < 2; ++b)
#pragma unroll
            for (int m = 0; m < 4; ++m)
#pragma unroll
                for (int n = 0; n < 2; ++n) acc[a][b][m][n] = (f32x4){0.f, 0.f, 0.f, 0.f};
    bf16x8 At[4][2], B0[2][2], B1[2][2];
    const char* cA = (const char*)g.A + (size_t)cur.pm * tstepA; const char* cB = (const char*)g.Bt + (size_t)cur.pn * tstepB;
    S.a_ready(cur);
    if constexpr (SP2) {
        PG8_STAGE(PG8_SB(0, 0), cB, voffB); PG8_STAGE(PG8_SB(0, 1), cB + hstepB, voffB); PG8_STAGE(PG8_SA(0, 0), cA, voffA); PG8_STAGE(PG8_SA(0, 1), cA + hstepA, voffA);
        if (wr == 1) PG8_BAR;
        PG8_WAIT_V(2); PG8_BAR;
        PG8_STAGE(PG8_SB(1, 0), cB + kstep, voffB); PG8_STAGE(PG8_SA(1, 0), cA + kstep, voffA); PG8_STAGE(PG8_SB(1, 1), cB + hstepB + kstep, voffB);
        PG8_WAIT_V(6); PG8_BAR;
    } else {
        PG8_STAGE(PG8_SB(0, 0), cB, voffB); PG8_STAGE(PG8_SA(0, 0), cA, voffA); PG8_STAGE(PG8_SB(0, 1), cB + hstepB, voffB); PG8_STAGE(PG8_SA(0, 1), cA + hstepA, voffA);
        if (wr == 1) PG8_BAR;
        PG8_WAIT_V(4); PG8_BAR;
        PG8_STAGE(PG8_SB(1, 0), cB + kstep, voffB); PG8_STAGE(PG8_SA(1, 0), cA + kstep, voffA); PG8_STAGE(PG8_SB(1, 1), cB + hstepB + kstep, voffB);
        PG8_WAIT_V(6); PG8_BAR;
    }
    for (;;) {
        const bool has_next = S.next(ui + 1, nxt);
        const char* nA = has_next ? (const char*)g.A + (size_t)nxt.pm * tstepA : cA; const char* nB = has_next ? (const char*)g.Bt + (size_t)nxt.pn * tstepB : cB;
        for (int t = 0; t < nt; t += 2) {
            const bool last = (t == nt - 2);
            const char* a1 = cA + (size_t)(t + 1) * kstep;
            const char* a2 = last ? nA : cA + (size_t)(t + 2) * kstep; const char* b2 = last ? nB : cB + (size_t)(t + 2) * kstep;
            const char* a3 = a2 + kstep; const char* b3 = b2 + kstep;
            if (last && has_next) S.a_ready(nxt);
            if constexpr (SP2) {
            PG8_LDB(B0, 0, 0); PG8_LDB(B1, 0, 1); PG8_SCHED; PG8_LDA(At, 0, 0); PG8_STAGE(PG8_SA(1, 1), a1 + hstepA, voffA);
            PG8_WAIT_V(8); PG8_WAIT_L(0); PG8_BAR; PG8_MMA(0, 0, At, B0); PG8_MMA(0, 1, At, B1); PG8_BAR; PG8_SCHED;
            PG8_LDA(At, 0, 1); PG8_STAGE(PG8_SB(0, 0), b2, voffB); PG8_STAGE(PG8_SB(0, 1), b2 + hstepB, voffB); PG8_STAGE(PG8_SA(0, 0), a2, voffA);
            PG8_WAIT_V(8); PG8_WAIT_L(0); PG8_BAR; PG8_MMA(1, 0, At, B0); PG8_MMA(1, 1, At, B1); PG8_BAR; PG8_SCHED;
            PG8_LDB(B0, 1, 0); PG8_LDB(B1, 1, 1); PG8_SCHED; PG8_LDA(At, 1, 0); PG8_STAGE(PG8_SA(0, 1), a2 + hstepA, voffA);
            PG8_WAIT_V(8); PG8_WAIT_L(0); PG8_BAR; PG8_MMA(0, 0, At, B0); PG8_MMA(0, 1, At, B1); PG8_BAR; PG8_SCHED;
            PG8_LDA(At, 1, 1); PG8_STAGE(PG8_SB(1, 0), b3, voffB); PG8_STAGE(PG8_SB(1, 1), b3 + hstepB, voffB); PG8_STAGE(PG8_SA(1, 0), a3, voffA);
            PG8_WAIT_V(8); PG8_WAIT_L(0); PG8_BAR; PG8_MMA(1, 0, At, B0); PG8_MMA(1, 1, At, B1); PG8_BAR; PG8_SCHED;
            } else {
            PG8_LDB(B0, 0, 0); PG8_SCHED; PG8_LDA(At, 0, 0); PG8_STAGE(PG8_SA(1, 1), a1 + hstepA, voffA);
            PG8_WAIT_L(8); PG8_BAR; PG8_WAIT_L(0); PG8_MMA(0, 0, At, B0); PG8_BAR; PG8_SCHED;
            PG8_LDB(B1, 0, 1); PG8_STAGE(PG8_SB(0, 0), b2, voffB);
            PG8_BAR; PG8_WAIT_L(0); PG8_MMA(0, 1, At, B1); PG8_BAR;
            PG8_LDA(At, 0, 1); PG8_STAGE(PG8_SA(0, 0), a2, voffA);
            PG8_BAR; PG8_WAIT_L(0); PG8_MMA(1, 0, At, B0); PG8_BAR; PG8_SCHED;
            PG8_STAGE(PG8_SB(0, 1), b2 + hstepB, voffB);
            PG8_WAIT_V(6); PG8_BAR; PG8_MMA(1, 1, At, B1); PG8_BAR;
            PG8_LDB(B0, 1, 0); PG8_SCHED; PG8_LDA(At, 1, 0); PG8_STAGE(PG8_SA(0, 1), a2 + hstepA, voffA);
            PG8_WAIT_L(8); PG8_BAR; PG8_WAIT_L(0); PG8_MMA(0, 0, At, B0); PG8_BAR; PG8_SCHED;
            PG8_LDB(B1, 1, 1); PG8_STAGE(PG8_SB(1, 0), b3, voffB);
            PG8_BAR; PG8_WAIT_L(0); PG8_MMA(0, 1, At, B1); PG8_BAR;
            PG8_LDA(At, 1, 1); PG8_STAGE(PG8_SA(1, 0), a3, voffA);
            PG8_BAR; PG8_WAIT_L(0); PG8_MMA(1, 0, At, B0); PG8_BAR; PG8_SCHED;
            PG8_STAGE(PG8_SB(1, 1), b3 + hstepB, voffB);
            PG8_WAIT_V(6); PG8_BAR; PG8_MMA(1, 1, At, B1); PG8_BAR;
            }
        }
        if constexpr (ALIGN_EPI) { if (wr == 0) PG8_BAR; }
        if constexpr (!Epi::AFTER_DRAIN) { E(acc, cur, wr, wc, fr, fq); S.done(cur); }
        if (!has_next) break;
#pragma unroll
        for (int a = 0; a < 2; ++a)
#pragma unroll
            for (int b = 0; b < 2; ++b)
#pragma unroll
                for (int m = 0; m < 4; ++m)
#pragma unroll
                    for (int n = 0; n < 2; ++n) acc[a][b][m][n] = (f32x4){0.f, 0.f, 0.f, 0.f};
        cur = nxt; cA = nA; cB = nB; ++ui;
        if constexpr (ALIGN_EPI) { if (wr == 1) PG8_BAR; }
    }
    PG8_WAIT_V(0);
    if constexpr (!ALIGN_EPI) { if (wr == 0) PG8_BAR; }
    PG8_BAR;
    if constexpr (Epi::AFTER_DRAIN) { E.fused(acc, cur, wr, wc, fr, fq, lds, wid, lane); S.done(cur); }
#undef PG8_SA
#undef PG8_SB
#undef PG8_STAGE
#undef PG8_LDA
#undef PG8_LDB
#undef PG8_MMA
#undef PG8_WAIT_V
#undef PG8_WAIT_L
#undef PG8_BAR
#undef PG8_SCHED
}
}

using pg8::bf16_t; using pg8::f32x4; using pg8::u32x4; using pg8::u32x2; using pg8::bf16x8; using pg8::Unit; using pg8::cvt_pk_bf16;
#define LAS __attribute__((address_space(3)))
typedef float f32x2 __attribute__((ext_vector_type(2)));
constexpr int D = 1024, M = 40960, MCTX = 8192, FF = 2816, NIN = 2304, NT = 512, NWAVES = 8;
constexpr float LOG2E = 1.4426950408889634f, RMS_EPS = 1e-6f, QSCALE = 0.125f * 1.4426950408889634f;
constexpr size_t OUT_K = 41943040, OUT_V = 44040192, OUT_LRU = 46137344, OUT_SSM = 46202880;
constexpr int LDS_BYTES = 163840, MISC_OFF = 163840 - 256;
constexpr int NCHUNK = 2560;
constexpr size_t MiB = 1u << 20;
constexpr size_t WS_MOD = 1 * MiB, WS_ROPE = 2 * MiB, WS_APOW = 3 * MiB, WS_BBAR = 4 * MiB, WS_WL = 5 * MiB, WS_CK = 6 * MiB, WS_CVT = 7 * MiB, WS_AGG = 8 * MiB, WS_CIN = 13 * MiB,
    WS_TT = 16 * MiB, WS_PT = 24 * MiB, WS_WGU0 = 28 * MiB, WS_WGU1 = 39 * MiB, WS_WD0 = 50 * MiB, WS_WD1 = 50 * MiB + 5632 * 1024, WS_WIN = 61 * MiB, WS_WGLU = 61 * MiB + 10752 * 1024,
    WS_WOL = WS_WGLU + 2 * MiB, WS_WOA = WS_WOL + 1 * MiB, WS_WOUT = WS_WOA + 1 * MiB, WS_H = 78 * MiB, WS_F = 158 * MiB, WS_R = 238 * MiB, WS_F2 = 458 * MiB, WS_END = 474 * MiB;
constexpr int MSPLIT = 32768;
constexpr size_t WS_QB = WS_R, WS_YL = WS_R + 40 * MiB, WS_UH = WS_R + 80 * MiB, WS_S5Y = WS_R + 160 * MiB, WS_ACT = WS_R;
constexpr size_t WS_XL = WS_F, WS_KB = WS_F + 40 * MiB, WS_VT = WS_F + 50 * MiB, WS_MERGED = WS_F, WS_SCR = WS_UH;
static_assert(WS_WOUT + 2 * MiB <= WS_H, "ws map");

__device__ __forceinline__ float bf2f(unsigned h) { return __uint_as_float(h << 16); }
__device__ __forceinline__ float bflo(unsigned w) { return __uint_as_float(w << 16); }
__device__ __forceinline__ float bfhi(unsigned w) { return __uint_as_float(w & 0xffff0000u); }
__device__ __forceinline__ unsigned f2bf(float f) { unsigned u = __float_as_uint(f); return (u + 0x7fffu + ((u >> 16) & 1u)) >> 16; }
__device__ __forceinline__ float sigm(float x) { return 1.f / (1.f + __expf(-x)); }
__device__ __forceinline__ float sigm_f(float x) { return __builtin_amdgcn_rcpf(1.f + __builtin_amdgcn_exp2f(x * -1.4426950408889634f)); }
__device__ __forceinline__ float gelu_f(float x) { const float z = x * (1.0f + 0.044715f * x * x); return x * __builtin_amdgcn_rcpf(1.f + __builtin_amdgcn_exp2f(z * (-2.f * 0.7978845608028654f * 1.4426950408889634f))); }
__device__ __forceinline__ float gelu_t(float x) { const float z = 0.7978845608028654f * (x + 0.044715f * x * x * x); return x / (1.f + __expf(-2.f * z)); }
__device__ __forceinline__ float shx(float v, int mask, int lane) { return __int_as_float(__builtin_amdgcn_ds_bpermute((lane ^ mask) << 2, __float_as_int(v))); }
__device__ __forceinline__ float wave_sum(float v, int lane) {
#pragma unroll
    for (int o = 1; o < 64; o <<= 1) v += shx(v, o, lane);
    return v;
}
__device__ __forceinline__ u32x4 pack8(const f32x4 a, const f32x4 b) { u32x4 w; w.x = cvt_pk_bf16(a[0], a[1]); w.y = cvt_pk_bf16(a[2], a[3]); w.z = cvt_pk_bf16(b[0], b[1]); w.w = cvt_pk_bf16(b[2], b[3]); return w; }
__device__ __forceinline__ u32x2 pack4(const f32x4 a) { u32x2 w; w.x = cvt_pk_bf16(a[0], a[1]); w.y = cvt_pk_bf16(a[2], a[3]); return w; }

struct Params { const float* in[36]; float* out; unsigned char* ws; int ph_lo, ph_hi; };
typedef const __attribute__((address_space(4))) Params CParams;

#define XB_TMO      128
#define XB_XCNT(j)  (256  + 64 * (j))
#define XB_XSUB(j)  (1280 + 64 * (j))
#define XB_XGEN(j)  (2304 + 64 * (j))
#define XB_TOP      3328
#define XB_TOPGEN   3392
#define XCD_BAR_WORDS 3456
#define XB_SPIN_CAP (1u << 18)

__device__ __forceinline__ unsigned xb_ld(unsigned* p)              { return __hip_atomic_load(p, __ATOMIC_RELAXED, __HIP_MEMORY_SCOPE_AGENT); }
__device__ __forceinline__ unsigned xb_add(unsigned* p, unsigned v) { return __hip_atomic_fetch_add(p, v, __ATOMIC_RELAXED, __HIP_MEMORY_SCOPE_AGENT); }
__device__ __forceinline__ unsigned xb_xcc_id() { return (unsigned)__builtin_amdgcn_s_getreg((3 << 11) | 20) & 0xFu; }
#define XB_SPIN(cond, bar) do { unsigned _sp = 0; while (cond) { __builtin_amdgcn_s_sleep(1); \
    if ((++_sp & 255u) == 0u) { if (xb_ld(&(bar)[XB_TMO])) break; if (_sp > XB_SPIN_CAP) { atomicAdd(&(bar)[XB_TMO], 1u); break; } } } } while (0)

struct XcdBarrier {
    unsigned* bar; unsigned x;
    volatile LAS unsigned* st;
};

__device__ __forceinline__ XcdBarrier xcd_barrier_post(unsigned* bar, volatile LAS unsigned* st) {
    XcdBarrier b; b.bar = bar; b.x = xb_xcc_id(); b.st = st;
    if (threadIdx.x == 0) (void)xb_add(&bar[XB_XCNT(b.x)], 1u);
    return b;
}
__device__ __forceinline__ void xcd_barrier_complete(unsigned* bar, unsigned x, unsigned& nloc, unsigned& nx) {
    const unsigned G = gridDim.x * gridDim.y * gridDim.z;
    unsigned sum, cnt, mine, sp = 0u;
    for (;;) {
        sum = 0u; cnt = 0u; mine = 0u;
#pragma unroll
        for (unsigned j = 0; j < 16; ++j) { const unsigned c = xb_ld(&bar[XB_XCNT(j)]); sum += c; cnt += (c > 0u) ? 1u : 0u; mine = (j == x) ? c : mine; }
        if (sum == G) break;
        __builtin_amdgcn_s_sleep(1);
        if ((++sp & 255u) == 0u) { if (xb_ld(&bar[XB_TMO])) break; if (sp > XB_SPIN_CAP) { atomicAdd(&bar[XB_TMO], 1u); break; } }
    }
    nloc = mine > 0u ? mine : 1u; nx = cnt > 0u ? cnt : 1u;
}

__device__ __forceinline__ void xcd_barrier(const XcdBarrier& b) {
    asm volatile("s_waitcnt vmcnt(0)" ::: "memory");
    __syncthreads();
    if (threadIdx.x == 0) {
        unsigned* bar = b.bar;
        __builtin_amdgcn_s_waitcnt(0);
        unsigned nloc = b.st[0], nx = b.st[1];
        if (nloc == 0u) { xcd_barrier_complete(bar, b.x, nloc, nx); b.st[0] = nloc; b.st[1] = nx; }
        const unsigned old = xb_add(&bar[XB_XSUB(b.x)], 1u);
        const unsigned gen = old / nloc;
        if (old + 1u == (gen + 1u) * nloc) {
            __builtin_amdgcn_fence(__ATOMIC_RELEASE, "agent");
            asm volatile("s_waitcnt vmcnt(0)" ::: "memory");
            const unsigned og = xb_add(&bar[XB_TOP], 1u);
            const unsigned tg = og / nx;
            if (og + 1u == (tg + 1u) * nx) xb_add(&bar[XB_TOPGEN], 1u);
            else XB_SPIN(xb_ld(&bar[XB_TOPGEN]) == tg, bar);
            __builtin_amdgcn_fence(__ATOMIC_ACQUIRE, "agent");
            xb_add(&bar[XB_XGEN(b.x)], 1u);
            asm volatile("s_waitcnt vmcnt(0)" ::: "memory");
        } else {
            XB_SPIN(xb_ld(&bar[XB_XGEN(b.x)]) == gen, bar);
            __builtin_amdgcn_fence(__ATOMIC_ACQUIRE, "agent");
            asm volatile("s_waitcnt vmcnt(0)" ::: "memory");
        }
    }
    __syncthreads();
}

struct EpiPlain {
    static constexpr bool PERM = true, AFTER_DRAIN = false; bf16_t* O; int ldc;
    __device__ __forceinline__ void operator()(const f32x4 (&acc)[2][2][4][2], const Unit& u, int wr, int wc, int fr, int fq) const {
        const int row0 = u.pm * 256 + wr * 64 + fr, col0 = u.pn * 256 + wc * 32 + 8 * fq;
#pragma unroll
        for (int ai = 0; ai < 2; ++ai)
#pragma unroll
            for (int m = 0; m < 4; ++m) { bf16_t* rowp = O + (size_t)(row0 + ai * 128 + m * 16) * ldc + col0;
#pragma unroll
                for (int bj = 0; bj < 2; ++bj) *(u32x4*)(rowp + bj * 128) = pack8(acc[ai][bj][m][0], acc[ai][bj][m][1]); }
    }
};
struct EpiSwiGLU {
    static constexpr bool PERM = false, AFTER_DRAIN = false; bf16_t* O;
    __device__ __forceinline__ void operator()(const f32x4 (&acc)[2][2][4][2], const Unit& u, int wr, int wc, int fr, int fq) const {
        const int row0 = u.pm * 256 + wr * 64 + fr, col0 = u.pn * 128 + wc * 16 + 4 * fq;
#pragma unroll
        for (int ai = 0; ai < 2; ++ai)
#pragma unroll
            for (int m = 0; m < 4; ++m) { bf16_t* rowp = O + (size_t)(row0 + ai * 128 + m * 16) * FF + col0;
#pragma unroll
                for (int bj = 0; bj < 2; ++bj) { const f32x4 g = acc[ai][bj][m][0], up = acc[ai][bj][m][1]; f32x4 a;
#pragma unroll
                    for (int j = 0; j < 4; ++j) a[j] = g[j] * sigm_f(g[j]) * up[j];
                    *(u32x2*)(rowp + bj * 64) = pack4(a); } }
    }
};
struct EpiIn {
    static constexpr bool PERM = false, AFTER_DRAIN = false;
    bf16_t *QB, *KB, *VT, *XL, *YL, *UH; float* out; const float* rope; int l;
    __device__ __forceinline__ void operator()(const f32x4 (&acc)[2][2][4][2], const Unit& u, int wr, int wc, int fr, int fq) const {
        const int pn = u.pn; const bool lat = u.pm >= 32;
#pragma unroll
        for (int ai = 0; ai < 2; ++ai)
#pragma unroll
            for (int m = 0; m < 4; ++m) {
                const int row = u.pm * 256 + ai * 128 + wr * 64 + m * 16 + fr;
                const int t = lat ? ((row - MCTX) & 4095) : (row & 255);
#pragma unroll
                for (int bj = 0; bj < 2; ++bj) {
                    f32x4 v0 = acc[ai][bj][m][0], v1 = acc[ai][bj][m][1];
                    const int cb = 128 * bj + 32 * wc;
                    if (pn <= 2) {
                        const bool isq = pn < 2, isv = (pn == 2 && bj == 1);
                        if (lat && !isv) {
                            const int pos = (wc & 1) ? (t & 63) : (t >> 6);
                            const f32x4* rp = (const f32x4*)(rope + (pos * 16 + 4 * fq) * 2);
                            const f32x4 c01 = rp[0], c23 = rp[1];
                            const float cs[4] = {c01[0], c01[2], c23[0], c23[2]}, sn[4] = {c01[1], c01[3], c23[1], c23[3]};
#pragma unroll
                            for (int j = 0; j < 4; ++j) { const float x1 = v0[j], x2 = v1[j]; v0[j] = x1 * cs[j] - x2 * sn[j]; v1[j] = x2 * cs[j] + x1 * sn[j]; }
                        }
                        if (isq) { v0 = v0 * QSCALE; v1 = v1 * QSCALE; bf16_t* p = QB + (size_t)row * 512 + pn * 256 + cb + 4 * fq; *(u32x2*)p = pack4(v0); *(u32x2*)(p + 16) = pack4(v1); }
                        else {
                            const int kc = 32 * wc + 4 * fq;
                            if (!lat) { float* o = out + (bj ? OUT_V : OUT_K) + ((size_t)(((row >> 8) * 2 + l) * 256 + (row & 255))) * 128 + kc; *(f32x4*)o = v0; *(f32x4*)(o + 16) = v1; }
                            if (!isv) { bf16_t* p = KB + (size_t)row * 128 + kc; *(u32x2*)p = pack4(v0); *(u32x2*)(p + 16) = pack4(v1); }
                            else {
#pragma unroll
                                for (int j = 0; j < 4; ++j) { VT[(size_t)(kc + j) * M + row] = (bf16_t)f2bf(v0[j]); VT[(size_t)(kc + 16 + j) * M + row] = (bf16_t)f2bf(v1[j]); }
                            }
                        }
                    } else if (pn <= 6) {
                        bf16_t* p = (pn <= 4 ? XL : YL) + (size_t)row * 512 + ((pn - 3) & 1) * 256 + cb + 4 * fq; *(u32x2*)p = pack4(v0); *(u32x2*)(p + 16) = pack4(v1);
                    } else {
                        const int g0 = 16 * (pn - 7) + 8 * bj + 2 * wc;
                        bf16_t* p = UH + ((size_t)g0 * NCHUNK + (row >> 4)) * 512 + (row & 15) * 16 + 4 * fq;
                        *(u32x2*)p = pack4(v0); *(u32x2*)(p + (size_t)NCHUNK * 512) = pack4(v1);
                    }
                }
            }
    }
};
struct EpiS5State {
    static constexpr bool PERM = false, AFTER_DRAIN = true;
    bf16_t* UH; const float* apow; const float* init; float* out; int l;
    __device__ __forceinline__ void fused(f32x4 (&acc)[2][2][4][2], const Unit& u, int wr, int wc, int fr, int fq, PG8_LAS unsigned char* lds, int wid, int lane) const {
        const int g = u.pn, ti = u.pm - 10 * g, tid = wid * 64 + lane; const bool ctx = ti < 2;
        LAS float* T = (LAS float*)lds;
#pragma unroll
        for (int dir = 0; dir < 2; ++dir) {
#pragma unroll
            for (int ai = 0; ai < 2; ++ai)
#pragma unroll
                for (int m = 0; m < 4; ++m)
#pragma unroll
                    for (int n = 0; n < 2; ++n) *(LAS f32x4*)(T + (ai * 128 + wr * 64 + m * 16 + fr) * 132 + 32 * wc + 16 * n + 4 * fq) = acc[ai][dir][m][n];
            __syncthreads();
            if (tid < 64) {
                const int n = tid; const float* ap = apow + ((((size_t)dir * 32 + g) * 64 + n) * 17 + 16) * 2; const float ar = ap[0], aim = ap[1];
                float hr = 0.f, hi = 0.f;
                if (!ctx) { const size_t ib = ((((size_t)(ti - 2) * 2 + l) * 2 + dir) * 2) * 2048 + g * 64 + n; hr = init[ib]; hi = init[ib + 2048]; }
                for (int c0 = 0; c0 < 256; c0 += 8) {
                    float sr[8], si[8];
#pragma unroll
                    for (int k = 0; k < 8; ++k) { const int c = dir ? 255 - (c0 + k) : c0 + k; sr[k] = T[c * 132 + n]; si[k] = T[c * 132 + 64 + n]; }
#pragma unroll
                    for (int k = 0; k < 8; ++k) { const int cc = c0 + k, c = dir ? 255 - cc : cc;
                        if (ctx && (cc & 15) == 0) { hr = 0.f; hi = 0.f; }
                        T[c * 132 + n] = hr; T[c * 132 + 64 + n] = hi;
                        const float nr = ar * hr - aim * hi + sr[k], ni = ar * hi + aim * hr + si[k]; hr = nr; hi = ni;
                        if (ctx && (cc & 15) == 15) { const int seq = ti * 16 + (c >> 4); const size_t ob = OUT_SSM + ((((size_t)seq * 2 + l) * 2 + dir) * 2) * 2048 + g * 64 + n; out[ob] = hr; out[ob + 2048] = hi; }
                    }
                }
            }
            __syncthreads();
            { const int row = tid >> 1, half = tid & 1; const LAS float* s = T + row * 132 + half * 64;
              bf16_t* d = UH + ((size_t)g * NCHUNK + ti * 256 + row) * 512 + 256 + dir * 128 + half * 64;
#pragma unroll
              for (int c8 = 0; c8 < 8; ++c8) { const f32x4 a = *(const LAS f32x4*)(s + c8 * 8), b = *(const LAS f32x4*)(s + c8 * 8 + 4); *(u32x4*)(d + c8 * 8) = pack8(a, b); } }
            __syncthreads();
        }
    }
};
struct EpiS5Out {
    static constexpr bool PERM = true, AFTER_DRAIN = false; const bf16_t* UH; bf16_t* S5Y; const float* dvec;
    __device__ __forceinline__ void operator()(const f32x4 (&acc)[2][2][4][2], const Unit& u, int wr, int wc, int fr, int fq) const {
        const int g = u.pn, ti = u.pm - 10 * g, co0 = 8 * (fq & 1);
        const f32x4 d0 = *(const f32x4*)(dvec + 16 * g + co0), d1 = *(const f32x4*)(dvec + 16 * g + co0 + 4);
#pragma unroll
        for (int ai = 0; ai < 2; ++ai)
#pragma unroll
            for (int m = 0; m < 4; ++m) { const int cidx = ti * 256 + ai * 128 + wr * 64 + m * 16 + fr;
#pragma unroll
                for (int bj = 0; bj < 2; ++bj) { const int t = 8 * bj + 2 * wc + (fq >> 1);
                    const u32x4 uu = *(const u32x4*)(UH + ((size_t)g * NCHUNK + cidx) * 512 + t * 16 + co0);
                    f32x4 a = acc[ai][bj][m][0], b = acc[ai][bj][m][1];
                    a[0] = gelu_f(a[0] + d0[0] * bflo(uu.x)); a[1] = gelu_f(a[1] + d0[1] * bfhi(uu.x)); a[2] = gelu_f(a[2] + d0[2] * bflo(uu.y)); a[3] = gelu_f(a[3] + d0[3] * bfhi(uu.y));
                    b[0] = gelu_f(b[0] + d1[0] * bflo(uu.z)); b[1] = gelu_f(b[1] + d1[1] * bfhi(uu.z)); b[2] = gelu_f(b[2] + d1[2] * bflo(uu.w)); b[3] = gelu_f(b[3] + d1[3] * bfhi(uu.w));
                    *(u32x4*)(S5Y + ((size_t)cidx * 16 + t) * 512 + 16 * g + co0) = pack8(a, b); }
                asm volatile("" ::: "memory"); }
    }
};
template <int MODE> struct EpiMerge {
    static constexpr bool PERM = true, AFTER_DRAIN = false; u32x4* scr; bf16_t* O;
    __device__ __forceinline__ void operator()(const f32x4 (&acc)[2][2][4][2], const Unit& u, int wr, int wc, int fr, int fq) const {
        const int tid = pg8::opaque_tid(); u32x4* G = scr + tid; u32x4* MG = scr + 8192 + tid;
        const int row0 = u.pm * 256 + wr * 64 + fr, col0 = u.pn * 256 + wc * 32 + 8 * fq;
#pragma unroll
        for (int ai = 0; ai < 2; ++ai)
#pragma unroll
            for (int m = 0; m < 4; ++m)
#pragma unroll
                for (int bj = 0; bj < 2; ++bj) { const int i = (ai * 4 + m) * 2 + bj; f32x4 a = acc[ai][bj][m][0], b = acc[ai][bj][m][1];
                    if (MODE == 0) {
#pragma unroll
                        for (int j = 0; j < 4; ++j) { a[j] = sigm_f(a[j]); b[j] = sigm_f(b[j]); }
                        G[i * 512] = pack8(a, b);
                    } else {
                        const u32x4 gw = G[i * 512]; const f32x4 ga = {bflo(gw.x), bfhi(gw.x), bflo(gw.y), bfhi(gw.y)}, gb = {bflo(gw.z), bfhi(gw.z), bflo(gw.w), bfhi(gw.w)};
                        if (MODE == 1) MG[i * 512] = pack8(ga * a, gb * b);
                        else if (MODE == 2) G[i * 512] = pack8(ga * a, gb * b);
                        else { const u32x4 mw = MG[i * 512]; const f32x4 ma = {bflo(mw.x), bfhi(mw.x), bflo(mw.y), bfhi(mw.y)}, mb = {bflo(mw.z), bfhi(mw.z), bflo(mw.w), bfhi(mw.w)};
                            if (MODE == 3) {
#pragma unroll
                                for (int j = 0; j < 4; ++j) { a[j] = sigm_f(a[j]); b[j] = sigm_f(b[j]); }
                                MG[i * 512] = pack8(ma + ga * a, mb + gb * b);
                            } else *(u32x4*)(O + (size_t)(row0 + ai * 128 + m * 16) * D + col0 + bj * 128) = pack8(ma + ga * a, mb + gb * b);
                        }
                    }
                    if (bj == 1) asm volatile("" ::: "memory");
                }
    }
};

struct MergeOrder {
    pg8::Order base; int mode;
    __device__ bool next(int i, Unit& u) const {
        Unit t; if (!base.next(0, t)) return false;
        if (mode == 0) { if (i >= 3) return false; u.pm = t.pm; u.pn = t.pn + 4 * i; return true; }
        if (i >= 4) return false;
        if (i == 0) { u.pm = t.pm + 160; u.pn = 8 + t.pn; } else if (i == 1) { u.pm = t.pm + 640; u.pn = t.pn; } else if (i == 2) { u.pm = t.pm + 640; u.pn = 4 + t.pn; } else { u.pm = t.pm; u.pn = 12 + t.pn; }
        return true;
    }
    __device__ __forceinline__ void a_ready(const Unit&) const {}
    __device__ __forceinline__ void done(const Unit&) const {}
};
__device__ __forceinline__ void unpack8(const u32x4 w, f32x4& a, f32x4& b) { a = (f32x4){bflo(w.x), bfhi(w.x), bflo(w.y), bfhi(w.y)}; b = (f32x4){bflo(w.z), bfhi(w.z), bflo(w.w), bfhi(w.w)}; }
#define SLOT2(i) ((i) < 8 ? s2lo + (i) * 512 : s2hi + ((i) - 8) * 512)
struct EpiGates {
    static constexpr bool PERM = true, AFTER_DRAIN = false; u32x4 *s01, *s2lo, *s2hi;
    __device__ __forceinline__ void operator()(const f32x4 (&acc)[2][2][4][2], const Unit& u, int wr, int wc, int fr, int fq) const {
        const int tid = pg8::opaque_tid(), kind = u.pn >> 2;
#pragma unroll
        for (int ai = 0; ai < 2; ++ai)
#pragma unroll
            for (int m = 0; m < 4; ++m)
#pragma unroll
                for (int bj = 0; bj < 2; ++bj) { const int i = (ai * 4 + m) * 2 + bj; f32x4 a = acc[ai][bj][m][0], b = acc[ai][bj][m][1];
#pragma unroll
                    for (int j = 0; j < 4; ++j) { a[j] = sigm(a[j]); b[j] = sigm(b[j]); }
                    u32x4* d = kind == 0 ? s01 + i * 512 : (kind == 1 ? s01 + 8192 + i * 512 : SLOT2(i));
                    d[tid] = pack8(a, b); }
    }
};
struct EpiMix {
    static constexpr bool PERM = true, AFTER_DRAIN = false; u32x4 *s01, *s2lo, *s2hi; bf16_t* O;
    __device__ __forceinline__ void operator()(const f32x4 (&acc)[2][2][4][2], const Unit& u, int wr, int wc, int fr, int fq) const {
        const int tid = pg8::opaque_tid(), kind = u.pn >> 2;
        const int opm = u.pm % 160, opn = u.pn & 3, row0 = opm * 256 + wr * 64 + fr, col0 = opn * 256 + wc * 32 + 8 * fq;
#pragma unroll
        for (int ai = 0; ai < 2; ++ai)
#pragma unroll
            for (int m = 0; m < 4; ++m) {
#pragma unroll
                for (int bj = 0; bj < 2; ++bj) { const int i = (ai * 4 + m) * 2 + bj; f32x4 a = acc[ai][bj][m][0], b = acc[ai][bj][m][1];
                    u32x4* p0 = s01 + i * 512 + tid; u32x4* p1 = p0 + 8192; u32x4* p2 = SLOT2(i) + tid;
                    if (kind == 2) { f32x4 ga, gb; unpack8(*p0, ga, gb); *p0 = pack8(ga * a, gb * b); }
                    else if (kind == 0) { f32x4 ga, gb; unpack8(*p1, ga, gb); *p1 = pack8(ga * a, gb * b); }
                    else if (kind == 1) { f32x4 ga, gb, ma, mb; unpack8(*p1, ga, gb); unpack8(*p0, ma, mb);
#pragma unroll
                        for (int j = 0; j < 4; ++j) { a[j] = sigm(a[j]); b[j] = sigm(b[j]); }
                        *p0 = pack8(ma + ga * a, mb + gb * b); }
                    else { f32x4 ga, gb, ma, mb; unpack8(*p2, ga, gb); unpack8(*p0, ma, mb);
                        *(u32x4*)(O + (size_t)(row0 + ai * 128 + m * 16) * D + col0 + bj * 128) = pack8(ma + ga * a, mb + gb * b); }
                }
                asm volatile("" ::: "memory"); }
    }
};
__device__ __forceinline__ void transpose_item(const float* W, int K, int N, bf16_t* WT, int mode, LAS float* scr, int item, int lane) {
    const int nblk = N / 32, kb = item / nblk, nb = item % nblk, k0 = 64 * kb, n0 = 32 * nb;
    { const int kq = lane >> 3, n4 = (lane & 7) * 4;
      f32x4 v[8];
#pragma unroll
      for (int i = 0; i < 8; ++i) v[i] = __builtin_nontemporal_load((const f32x4*)(W + (size_t)(k0 + 8 * i + kq) * N + n0 + n4));
#pragma unroll
      for (int i = 0; i < 8; ++i) { LAS float* d = scr + (8 * i + kq) * 33 + n4; d[0] = v[i][0]; d[1] = v[i][1]; d[2] = v[i][2]; d[3] = v[i][3]; } }
    asm volatile("s_waitcnt lgkmcnt(0)" ::: "memory");
    const int c = lane & 7;
#pragma unroll
    for (int j = 0; j < 4; ++j) { const int n = (lane >> 3) + 8 * j; const LAS float* s = scr + (8 * c) * 33 + n;
        u32x4 o; o.x = cvt_pk_bf16(s[0 * 33], s[1 * 33]); o.y = cvt_pk_bf16(s[2 * 33], s[3 * 33]); o.z = cvt_pk_bf16(s[4 * 33], s[5 * 33]); o.w = cvt_pk_bf16(s[6 * 33], s[7 * 33]);
        const int gn = n0 + n, drow = mode == 0 ? gn : ((gn >> 4) * 32 + (gn & 15) + (mode == 2 ? 16 : 0));
        *(u32x4*)(WT + (size_t)drow * K + k0 + 8 * c) = o; }
    asm volatile("s_waitcnt lgkmcnt(0)" ::: "memory");
}
__device__ __forceinline__ void prep_phase(CParams& p, int l, LAS unsigned char* lds, const int G, const int bx) {
    const int tid = pg8::opaque_tid(), lane = tid & 63, wave = tid >> 6;
    unsigned char* ws = p.ws;
    {
        LAS float* scr = (LAS float*)(lds + wave * 8704);
        const int gw = bx * NWAVES + wave, NGW = G * NWAVES;
        constexpr int I_G = 16 * 88, I_D = 44 * 32, I_IN = 16 * 168, I_GLU = 8 * 64, I_O = 8 * 32, I_OUT = 16 * 32;
        constexpr int NITEMS = 4 * I_G + 2 * I_D + I_IN + I_GLU + 2 * I_O + I_OUT;
        const float* wg = p.in[12] + (size_t)l * 2 * D * FF; const float* wu = p.in[13] + (size_t)l * 2 * D * FF; const float* wd = p.in[14] + (size_t)l * 2 * FF * D;
        for (int it = gw; it < NITEMS; it += NGW) {
            int r = it;
            if (r < I_G) { transpose_item(wg, D, FF, (bf16_t*)(ws + WS_WGU0), 1, scr, r, lane); continue; } r -= I_G;
            if (r < I_G) { transpose_item(wu, D, FF, (bf16_t*)(ws + WS_WGU0), 2, scr, r, lane); continue; } r -= I_G;
            if (r < I_G) { transpose_item(wg + (size_t)D * FF, D, FF, (bf16_t*)(ws + WS_WGU1), 1, scr, r, lane); continue; } r -= I_G;
            if (r < I_G) { transpose_item(wu + (size_t)D * FF, D, FF, (bf16_t*)(ws + WS_WGU1), 2, scr, r, lane); continue; } r -= I_G;
            if (r < I_D) { transpose_item(wd, FF, D, (bf16_t*)(ws + WS_WD0), 0, scr, r, lane); continue; } r -= I_D;
            if (r < I_D) { transpose_item(wd + (size_t)FF * D, FF, D, (bf16_t*)(ws + WS_WD1), 0, scr, r, lane); continue; } r -= I_D;
            if (r < I_IN) { transpose_item(p.in[15] + (size_t)l * D * 5376, D, 5376, (bf16_t*)(ws + WS_WIN), 0, scr, r, lane); continue; } r -= I_IN;
            if (r < I_GLU) { transpose_item(p.in[31] + (size_t)l * 512 * 2048, 512, 2048, (bf16_t*)(ws + WS_WGLU), 0, scr, r, lane); continue; } r -= I_GLU;
            if (r < I_O) { transpose_item(p.in[33] + (size_t)l * 512 * D, 512, D, (bf16_t*)(ws + WS_WOL), 0, scr, r, lane); continue; } r -= I_O;
            if (r < I_O) { transpose_item(p.in[34] + (size_t)l * 512 * D, 512, D, (bf16_t*)(ws + WS_WOA), 0, scr, r, lane); continue; } r -= I_O;
            transpose_item(p.in[35] + (size_t)l * D * D, D, D, (bf16_t*)(ws + WS_WOUT), 0, scr, r, lane);
        }
    }
    const int gt = bx * NT + tid, NGT = G * NT;
    for (int i = gt; i < 4096; i += NGT) {
        const int dir = i >> 11, g = (i >> 6) & 31;
        const size_t li = ((size_t)l * 2 + dir) * 2048 + (i & 2047);
        const float lre = fminf(p.in[23][li], -1e-4f), lim = p.in[24][li], step = __expf(p.in[25][((size_t)l * 2 + dir) * 32 + g]);
        float* ap = (float*)(ws + WS_APOW) + (size_t)i * 34;
        const float mag1 = __expf(lre * step), ang1 = lim * step, abr = mag1 * __cosf(ang1), abi = mag1 * __sinf(ang1);
        { float pr = 1.f, pi = 0.f; for (int j = 0; j <= 16; ++j) { ap[2 * j] = pr; ap[2 * j + 1] = pi; const float nr = pr * abr - pi * abi, ni = pr * abi + pi * abr; pr = nr; pi = ni; } }
        const float den = lre * lre + lim * lim, nre = abr - 1.f;
        const float cre = (nre * lre + abi * lim) / den, cim = (abi * lre - nre * lim) / den;
        float* bb = (float*)(ws + WS_BBAR) + (size_t)i * 32;
        for (int ci = 0; ci < 16; ++ci) { const float br = p.in[26][li * 16 + ci], bi = p.in[27][li * 16 + ci]; bb[2 * ci] = cre * br - cim * bi; bb[2 * ci + 1] = cre * bi + cim * br; }
    }
    for (int i = gt; i < 8 * 512 * 128; i += NGT) {
        const int b = i >> 16, key = (i >> 7) & 511, c = i & 127, kvh = c >> 6, d = c & 63;
        const size_t src = (((size_t)b * 2 + l) * 512 + key) * 128 + c;
        ((bf16_t*)(ws + WS_CK))[(((size_t)b * 2 + kvh) * 512 + key) * 64 + d] = (bf16_t)f2bf(p.in[3][src]);
        ((bf16_t*)(ws + WS_CVT))[(((size_t)b * 2 + kvh) * 64 + d) * 512 + key] = (bf16_t)f2bf(p.in[4][src]);
    }
    for (int i = gt; i < 2 * 2 * 8 * 4096; i += NGT) {
        const int dir = i >> 16, gate = (i >> 15) & 1, blk = (i >> 12) & 7, o = (i >> 6) & 63, c = i & 63;
        const float* w = gate ? p.in[20] : p.in[18];
        ((bf16_t*)(ws + WS_WL))[i] = (bf16_t)f2bf(w[((((size_t)l * 2 + dir) * 8 + blk) * 64 + c) * 64 + o]);
    }
    if (l == 0) {
        for (int i = gt; i < 1024; i += NGT) { const int pos = i >> 4, k = i & 15; const float inv = __builtin_amdgcn_exp2f(-(float)k * (13.287712379549449f / 16.0f)); const float cs = __cosf((float)pos * inv), sn = __sinf((float)pos * inv);
            ((float*)(ws + WS_ROPE))[2 * i] = cs; ((float*)(ws + WS_ROPE))[2 * i + 1] = sn; }
        __syncthreads();
        LAS float* sv = (LAS float*)lds;
        LAS float* red = (LAS float*)(lds + 36864);
        for (int i = tid; i < 9 * 1024; i += NT) { const int v = i >> 10, k = i & 1023; const float x = v == 0 ? p.in[7][k] : p.in[2][(v - 1) * 1024 + k]; sv[i] = x * sigm(x); }
        __syncthreads();
        for (int it = bx; it < 288; it += G) {
            const int ll = it / 144, n0 = (it % 144) * 64, ks = tid >> 6, col = tid & 63;
            const float* w = p.in[8] + (size_t)ll * D * 9216 + n0 + col;
            float a[9];
#pragma unroll
            for (int v = 0; v < 9; ++v) a[v] = 0.f;
            for (int k = ks * 128; k < ks * 128 + 128; ++k) { const float wv = w[(size_t)k * 9216];
#pragma unroll
                for (int v = 0; v < 9; ++v) a[v] += sv[v * 1024 + k] * wv; }
#pragma unroll
            for (int v = 0; v < 9; ++v) red[(ks * 9 + v) * 64 + col] = a[v];
            __syncthreads();
            for (int i = tid; i < 576; i += NT) { const int v = i >> 6, cc = i & 63; float s = p.in[9][(size_t)ll * 9216 + n0 + cc];
#pragma unroll
                for (int k2 = 0; k2 < 8; ++k2) s += red[(k2 * 9 + v) * 64 + cc];
                ((float*)(ws + WS_MOD))[((size_t)ll * 9 + v) * 9216 + n0 + cc] = s; }
            __syncthreads();
        }
    }
}
__device__ __forceinline__ void prep2_phase(CParams& p, int l, const int G, const int bx) {
    const int tid = pg8::opaque_tid(), gt = bx * NT + tid, NGT = G * NT;
    const float* apow = (const float*)(p.ws + WS_APOW); const float* bbar = (const float*)(p.ws + WS_BBAR);
    bf16_t* TT = (bf16_t*)(p.ws + WS_TT); bf16_t* PT = (bf16_t*)(p.ws + WS_PT);
    for (int i = gt; i < 32 * 16 * 16 * 16; i += NGT) {
        const int s = i & 15, co = (i >> 4) & 15, t = (i >> 8) & 15, g = i >> 12;
        float a[16];
#pragma unroll
        for (int ci = 0; ci < 16; ++ci) a[ci] = 0.f;
#pragma unroll
        for (int dir = 0; dir < 2; ++dir) {
            if (dir == 0 ? (s > t) : (s < t)) continue;
            const int j = dir == 0 ? t - s : s - t;
            const float* cre = p.in[28] + ((((size_t)l * 2 + dir) * 32 + g) * 16 + co) * 64; const float* cim = p.in[29] + ((((size_t)l * 2 + dir) * 32 + g) * 16 + co) * 64;
            const float* ap = apow + (((size_t)dir * 32 + g) * 64) * 34 + 2 * j; const float* bb = bbar + (((size_t)dir * 32 + g) * 64) * 32;
            for (int n = 0; n < 64; ++n) {
                const float cr = cre[n], cm = cim[n], pr = ap[n * 34], pi = ap[n * 34 + 1];
                const float wr_ = cr * pr - cm * pi, wi_ = cr * pi + cm * pr;
                const f32x4* b4 = (const f32x4*)(bb + n * 32);
#pragma unroll
                for (int q = 0; q < 8; ++q) { const f32x4 v = b4[q]; a[2 * q] += wr_ * v[0] - wi_ * v[1]; a[2 * q + 1] += wr_ * v[2] - wi_ * v[3]; }
            }
        }
        bf16_t* d = TT + ((size_t)g * 256 + t * 16 + co) * 512 + s * 16;
        u32x4 o0, o1; o0.x = cvt_pk_bf16(a[0], a[1]); o0.y = cvt_pk_bf16(a[2], a[3]); o0.z = cvt_pk_bf16(a[4], a[5]); o0.w = cvt_pk_bf16(a[6], a[7]);
        o1.x = cvt_pk_bf16(a[8], a[9]); o1.y = cvt_pk_bf16(a[10], a[11]); o1.z = cvt_pk_bf16(a[12], a[13]); o1.w = cvt_pk_bf16(a[14], a[15]);
        *(u32x4*)d = o0; *(u32x4*)(d + 8) = o1;
    }
    for (int i = gt; i < 32 * 256 * 128; i += NGT) {
        const int n = i & 63, dir = (i >> 6) & 1, co = (i >> 7) & 15, t = (i >> 11) & 15, g = i >> 15;
        const size_t cb = ((((size_t)l * 2 + dir) * 32 + g) * 16 + co) * 64 + n; const float cr = p.in[28][cb], cm = p.in[29][cb];
        const float* ap = apow + (((size_t)dir * 32 + g) * 64 + n) * 34 + 2 * (dir == 0 ? t + 1 : 16 - t);
        const float wr_ = cr * ap[0] - cm * ap[1], wi_ = cr * ap[1] + cm * ap[0];
        bf16_t* d = TT + ((size_t)g * 256 + t * 16 + co) * 512 + 256 + dir * 128 + n;
        d[0] = (bf16_t)f2bf(wr_); d[64] = (bf16_t)f2bf(-wi_);
    }
    for (int i = gt; i < 32 * 2 * 64 * 256; i += NGT) {
        const int ci = i & 15, s = (i >> 4) & 15, n = (i >> 8) & 63, dir = (i >> 14) & 1, g = i >> 15;
        const float* ap = apow + (((size_t)dir * 32 + g) * 64 + n) * 34 + 2 * (dir == 0 ? 15 - s : s);
        const float* bb = bbar + (((size_t)dir * 32 + g) * 64 + n) * 32 + 2 * ci;
        const float vr = ap[0] * bb[0] - ap[1] * bb[1], vi = ap[0] * bb[1] + ap[1] * bb[0];
        bf16_t* d = PT + ((size_t)g * 256 + dir * 128 + n) * 256 + s * 16 + ci;
        d[0] = (bf16_t)f2bf(vr); d[64 * 256] = (bf16_t)f2bf(vi);
    }
}
__device__ __forceinline__ void row_phase(CParams& p, int l, int kind, const int G, const int bx, const int rlo = 0, const int rhi = M) {
    const int tid = pg8::opaque_tid(), lane = tid & 63, wave = tid >> 6;
    const float* modb = (const float*)(p.ws + WS_MOD);
    const bool upd = !(kind == 0 && l == 0), mkh = kind != 3;
    const int lu = (kind == 0 || kind == 3) ? (kind == 3 ? 1 : l - 1) : l;
    const int gidx = (kind == 0 || kind == 3) ? 8 : (kind == 1 ? 2 : 5), pidx = (kind == 0 || kind == 3) ? 2 : (kind == 1 ? 0 : 1);
    const float gs = kind == 2 ? 1.0f : 0.5f;
    const bf16_t* fsrc = (const bf16_t*)(p.ws + (kind == 2 ? WS_H : WS_F));
    const int hsub = kind == 0 ? 0 : kind;
    bf16_t* H = (bf16_t*)(p.ws + WS_H);
    const int nw = G * NWAVES; int per = (rhi - rlo + nw - 1) / nw; per += per & 1;
    const int r0 = rlo + (bx * NWAVES + wave) * per, r1 = (r0 + per) < rhi ? (r0 + per) : rhi;
    const bool from_in = (l == 0 && kind <= 1);
    const bf16_t* f2src = (const bf16_t*)(p.ws + WS_F2);
    int vcur = -1;
    f32x4 gg[4], pm[4], sh[4], xn[2][4]; u32x2 xnb[2][4], fn[2][4], fn2[2][4];
#define ROW_FETCH(r_) do { _Pragma("unroll") for (int q = 0; q < 2; ++q) { const int rr_ = (r_) + q; if (rr_ < r1) { \
        if (from_in) { const float* xs_ = rr_ < MCTX ? p.in[0] + (size_t)rr_ * D : p.in[1] + (size_t)(rr_ - MCTX) * D; \
            _Pragma("unroll") for (int j = 0; j < 4; ++j) xn[q][j] = __builtin_nontemporal_load((const f32x4*)(xs_ + 4 * lane + 256 * j)); } \
        else { const bf16_t* xs_ = (const bf16_t*)(p.out + (size_t)rr_ * D); \
            _Pragma("unroll") for (int j = 0; j < 4; ++j) xnb[q][j] = __builtin_nontemporal_load((const u32x2*)(xs_ + 4 * lane + 256 * j)); } \
        if (upd) { _Pragma("unroll") for (int j = 0; j < 4; ++j) { fn[q][j] = __builtin_nontemporal_load((const u32x2*)(fsrc + (size_t)rr_ * D + 4 * lane + 256 * j)); \
            if (rr_ >= MSPLIT) fn2[q][j] = __builtin_nontemporal_load((const u32x2*)(f2src + (size_t)(rr_ - MSPLIT) * D + 4 * lane + 256 * j)); } } } } } while (0)
    if (r0 < r1) ROW_FETCH(r0);
    for (int r = r0; r < r1; r += 2) {
        const int v = r < MCTX ? 0 : 1 + ((r - MCTX) >> 12);
        if (v != vcur) {
            vcur = v;
#pragma unroll
            for (int j = 0; j < 4; ++j) {
                if (upd) { const f32x4 ga = *(const f32x4*)(modb + ((size_t)lu * 9 + v) * 9216 + gidx * 1024 + 4 * lane + 256 * j), gq = *(const f32x4*)(p.in[11] + ((size_t)lu * 3 + pidx) * D + 4 * lane + 256 * j); gg[j] = ga * gq * gs; }
                if (mkh) { const float* mv = modb + ((size_t)l * 9 + v) * 9216 + hsub * 3 * 1024;
                    const f32x4 s_ = *(const f32x4*)(mv + 4 * lane + 256 * j), sc = *(const f32x4*)(mv + 1024 + 4 * lane + 256 * j), gq = *(const f32x4*)(p.in[10] + ((size_t)l * 3 + hsub) * D + 4 * lane + 256 * j);
                    pm[j] = gq * (sc + 1.0f); sh[j] = s_; }
            }
        }
        f32x4 x[2][4]; u32x2 fw[2][4], fw2[2][4];
#pragma unroll
        for (int q = 0; q < 2; ++q)
#pragma unroll
            for (int j = 0; j < 4; ++j) { x[q][j] = from_in ? xn[q][j] : (f32x4){bflo(xnb[q][j].x), bfhi(xnb[q][j].x), bflo(xnb[q][j].y), bfhi(xnb[q][j].y)}; fw[q][j] = fn[q][j]; fw2[q][j] = fn2[q][j]; }
        if (r + 2 < r1) ROW_FETCH(r + 2);
        const bool two = r + 1 < r1, hi2 = r >= MSPLIT;
        if (upd) {
            f32x4 f[2][4]; float ss[2] = {0.f, 0.f};
#pragma unroll
            for (int q = 0; q < 2; ++q)
#pragma unroll
                for (int j = 0; j < 4; ++j) { f[q][j] = (f32x4){bflo(fw[q][j].x), bfhi(fw[q][j].x), bflo(fw[q][j].y), bfhi(fw[q][j].y)}; if (hi2) f[q][j] = f[q][j] + (f32x4){bflo(fw2[q][j].x), bfhi(fw2[q][j].x), bflo(fw2[q][j].y), bfhi(fw2[q][j].y)};
                    ss[q] += f[q][j][0] * f[q][j][0] + f[q][j][1] * f[q][j][1] + f[q][j][2] * f[q][j][2] + f[q][j][3] * f[q][j][3]; }
#pragma unroll
            for (int o = 1; o < 64; o <<= 1) { ss[0] += shx(ss[0], o, lane); ss[1] += shx(ss[1], o, lane); }
#pragma unroll
            for (int q = 0; q < 2; ++q) { const float rstd = rsqrtf(ss[q] * (1.f / D) + RMS_EPS);
#pragma unroll
                for (int j = 0; j < 4; ++j) x[q][j] = x[q][j] + gg[j] * (f[q][j] * rstd); }
        }
#pragma unroll
        for (int q = 0; q < 2; ++q) { if (q == 1 && !two) break;
            if (kind == 3) {
#pragma unroll
                for (int j = 0; j < 4; ++j) __builtin_nontemporal_store(x[q][j], (f32x4*)(p.out + (size_t)(r + q) * D + 4 * lane + 256 * j));
            } else if (upd) {
#pragma unroll
                for (int j = 0; j < 4; ++j) __builtin_nontemporal_store(pack4(x[q][j]), (u32x2*)((bf16_t*)(p.out + (size_t)(r + q) * D) + 4 * lane + 256 * j));
            } }
        if (mkh) {
            float ss[2] = {0.f, 0.f};
#pragma unroll
            for (int q = 0; q < 2; ++q)
#pragma unroll
                for (int j = 0; j < 4; ++j) ss[q] += x[q][j][0] * x[q][j][0] + x[q][j][1] * x[q][j][1] + x[q][j][2] * x[q][j][2] + x[q][j][3] * x[q][j][3];
#pragma unroll
            for (int o = 1; o < 64; o <<= 1) { ss[0] += shx(ss[0], o, lane); ss[1] += shx(ss[1], o, lane); }
#pragma unroll
            for (int q = 0; q < 2; ++q) { if (q == 1 && !two) break; const float rstd = rsqrtf(ss[q] * (1.f / D) + RMS_EPS);
#pragma unroll
                for (int j = 0; j < 4; ++j) { const f32x4 h = (x[q][j] * rstd) * pm[j] + sh[j]; *(u32x2*)(H + (size_t)(r + q) * D + 4 * lane + 256 * j) = pack4(h); } }
        }
    }
#undef ROW_FETCH
}
template <int PASS> __device__ __forceinline__ void lru_pass(CParams& p, int l, LAS unsigned char* lds, const int G, const int bx, bf16_t* ydst) {
    const int tid = pg8::opaque_tid(), lane = tid & 63, wave = tid >> 6, fr = lane & 15, fq = lane >> 4;
    const int blk = bx & 7, ttstep = G >> 3;
    const bf16_t* XL = (const bf16_t*)(p.ws + WS_XL);
    LAS float* xc = (LAS float*)lds;
    LAS bf16_t* xb = (LAS bf16_t*)(lds + 16640);
    LAS float* AB = (LAS float*)(lds + 16640 + 9216);
    const int ct = tid >> 3, c0 = (tid & 7) * 8, cch = blk * 64 + c0;
    float wcv[4][8], bcv[8];
    {
        const float* bc = p.in[17] + (size_t)l * 512 + cch;
#pragma unroll
        for (int k = 0; k < 8; ++k) bcv[k] = bc[k];
#pragma unroll
        for (int j = 0; j < 4; ++j) { const float* wc = p.in[16] + ((size_t)l * 4 + j) * 512 + cch;
#pragma unroll
            for (int k = 0; k < 8; ++k) wcv[j][k] = wc[k]; }
    }
    const int dir = wave >> 2, tq = wave & 3;
    bf16x8 wfa[4][2], wfx[4][2]; float pba[4], pbx[4], psp[4];
    {
        const bf16_t* WL = (const bf16_t*)(p.ws + WS_WL) + ((size_t)(dir * 2) * 8 + blk) * 4096;
#pragma unroll
        for (int nb = 0; nb < 4; ++nb) {
#pragma unroll
            for (int kk = 0; kk < 2; ++kk) { wfa[nb][kk] = *(const bf16x8*)(WL + (16 * nb + fr) * 64 + 32 * kk + 8 * fq); wfx[nb][kk] = *(const bf16x8*)(WL + 8 * 4096 + (16 * nb + fr) * 64 + 32 * kk + 8 * fq); }
            const size_t pb = ((size_t)l * 2 + dir) * 512 + blk * 64 + 16 * nb + fr;
            pba[nb] = p.in[19][pb]; pbx[nb] = p.in[21][pb]; psp[nb] = -8.0f * 1.4426950408889634f * __logf(1.0f + __expf(-p.in[22][pb]));
        }
    }
    u32x4 xr[4]; u32x4 ylr; float cinr = 0.f;
#define LRU_FETCH(tt_) do { const int row0_ = (tt_) * 64; const int seqlen_ = row0_ < MCTX ? 256 : 4096, tp0_ = row0_ < MCTX ? (row0_ & 255) : ((row0_ - MCTX) & 4095); \
        _Pragma("unroll") for (int j = 0; j < 4; ++j) { const int tp = tp0_ + ct + j - 2; xr[j] = (u32x4){0u, 0u, 0u, 0u}; if (tp >= 0 && tp < seqlen_) xr[j] = *(const u32x4*)(XL + (size_t)(row0_ + ct + j - 2) * 512 + cch); } \
        if (PASS == 3) { ylr = *(const u32x4*)((const bf16_t*)(p.ws + WS_YL) + (size_t)(row0_ + ct) * 512 + cch); if (tid < 128) cinr = ((const float*)(p.ws + WS_CIN))[((size_t)(tid >> 6) * 640 + (tt_)) * 512 + blk * 64 + (tid & 63)]; } } while (0)
    const bool rebal = (G == 256);
    const int nown = rebal ? (bx < 64 ? 17 : 20) : (640 - (bx >> 3) + ttstep - 1) / ttstep, ntl = nown + ((rebal && bx >= 64) ? 1 : 0);
    const int ttx = ((bx & 63) >> 3) + 32 * (16 + (bx >> 6));
#define LRU_TT(q_) ((q_) < nown ? (bx >> 3) + (q_) * ttstep : ttx)
    if (ntl > 0) LRU_FETCH(LRU_TT(0));
    for (int q = 0; q < ntl; ++q) {
        const int tt = LRU_TT(q);
        {
            float a[8];
#pragma unroll
            for (int k = 0; k < 8; ++k) a[k] = bcv[k];
#pragma unroll
            for (int j = 0; j < 4; ++j) { const u32x4 w = xr[j];
                a[0] += bflo(w.x) * wcv[j][0]; a[1] += bfhi(w.x) * wcv[j][1]; a[2] += bflo(w.y) * wcv[j][2]; a[3] += bfhi(w.y) * wcv[j][3]; a[4] += bflo(w.z) * wcv[j][4]; a[5] += bfhi(w.z) * wcv[j][5]; a[6] += bflo(w.w) * wcv[j][6]; a[7] += bfhi(w.w) * wcv[j][7]; }
#pragma unroll
            for (int k = 0; k < 8; ++k) xc[ct * 65 + c0 + k] = a[k];
            u32x4 o; o.x = cvt_pk_bf16(a[0], a[1]); o.y = cvt_pk_bf16(a[2], a[3]); o.z = cvt_pk_bf16(a[4], a[5]); o.w = cvt_pk_bf16(a[6], a[7]);
            *(LAS u32x4*)(xb + ct * 72 + c0) = o;
        }
        u32x4 ylc; float cinc = 0.f; if (PASS == 3) { ylc = ylr; cinc = cinr; }
        if (q + 1 < ntl) LRU_FETCH(LRU_TT(q + 1));
        __syncthreads();
        {
            bf16x8 af[2];
#pragma unroll
            for (int kk = 0; kk < 2; ++kk) af[kk] = *(const LAS bf16x8*)(xb + (16 * tq + fr) * 72 + 32 * kk + 8 * fq);
#pragma unroll
            for (int nb = 0; nb < 4; ++nb) {
                f32x4 za = {0.f, 0.f, 0.f, 0.f}, zx = {0.f, 0.f, 0.f, 0.f};
#pragma unroll
                for (int kk = 0; kk < 2; ++kk) { za = __builtin_amdgcn_mfma_f32_16x16x32_bf16(af[kk], wfa[nb][kk], za, 0, 0, 0); zx = __builtin_amdgcn_mfma_f32_16x16x32_bf16(af[kk], wfx[nb][kk], zx, 0, 0, 0); }
                const int c = 16 * nb + fr;
#pragma unroll
                for (int j = 0; j < 4; ++j) { const int t = 16 * tq + 4 * fq + j;
                    const float r = sigm_f(za[j] + pba[nb]), ig = sigm_f(zx[j] + pbx[nb]), a = __builtin_amdgcn_exp2f(r * psp[nb]),
                        em = __builtin_fmaf(-a, a, 1.0f), b = __builtin_amdgcn_sqrtf(em) * (ig * xc[t * 65 + c]);
                    AB[(dir * 64 + t) * 64 + c] = a; AB[8192 + (dir * 64 + t) * 64 + c] = b; }
            }
        }
        __syncthreads();
        if (tid < 128) {
            const int sd = tid >> 6, c = tid & 63, ch = blk * 64 + c;
            LAS float* A = AB + sd * 4096 + c; LAS float* B = A + 8192;
            if (PASS == 1) {
                float P = 1.f, h = 0.f;
#pragma unroll 1
                for (int k0 = 0; k0 < 64; k0 += 8) { float a[8], b[8];
#pragma unroll
                    for (int k = 0; k < 8; ++k) { const int t = sd ? 63 - (k0 + k) : k0 + k; a[k] = A[t * 64]; b[k] = B[t * 64]; }
#pragma unroll
                    for (int k = 0; k < 8; ++k) { h = a[k] * h + b[k]; P *= a[k]; } }
                float* ag = (float*)(p.ws + WS_AGG) + (((size_t)sd * 640 + tt) * 512 + ch) * 2; ag[0] = P; ag[1] = h;
            } else {
                float h = cinc;
#pragma unroll 1
                for (int k0 = 0; k0 < 64; k0 += 8) { float a[8], b[8];
#pragma unroll
                    for (int k = 0; k < 8; ++k) { const int t = sd ? 63 - (k0 + k) : k0 + k; a[k] = A[t * 64]; b[k] = B[t * 64]; }
#pragma unroll
                    for (int k = 0; k < 8; ++k) { const int t = sd ? 63 - (k0 + k) : k0 + k; h = a[k] * h + b[k]; B[t * 64] = h; } }
            }
        }
        if (PASS == 3) {
            __syncthreads();
            bf16_t* yp = ydst + (size_t)(tt * 64 + ct) * 512 + cch;
            const u32x4 w = ylc; const float yl[8] = {bflo(w.x), bfhi(w.x), bflo(w.y), bfhi(w.y), bflo(w.z), bfhi(w.z), bflo(w.w), bfhi(w.w)};
            float o[8];
#pragma unroll
            for (int k = 0; k < 8; ++k) o[k] = (AB[8192 + ct * 64 + c0 + k] + AB[8192 + 4096 + ct * 64 + c0 + k]) * gelu_f(yl[k]);
            u32x4 ov; ov.x = cvt_pk_bf16(o[0], o[1]); ov.y = cvt_pk_bf16(o[2], o[3]); ov.z = cvt_pk_bf16(o[4], o[5]); ov.w = cvt_pk_bf16(o[6], o[7]);
            *(u32x4*)yp = ov;
        }
    }
#undef LRU_FETCH
#undef LRU_TT
    __syncthreads();
}
__device__ __forceinline__ void lru_carry(CParams& p, int l, const int G, const int bx) {
    const float* AGG = (const float*)(p.ws + WS_AGG); float* CIN = (float*)(p.ws + WS_CIN);
    for (int i = bx * NT + pg8::opaque_tid(); i < 40 * 2 * 512; i += G * NT) {
        const int ch = i & 511, dir = (i >> 9) & 1, seq = i >> 10;
        const bool ctx = seq < 32; const int nt = ctx ? 4 : 64, t0 = ctx ? seq * 4 : 128 + (seq - 32) * 64;
        float h = ctx ? 0.f : p.in[5][(((size_t)(seq - 32) * 2 + l) * 2 + dir) * 512 + ch];
        for (int k0 = 0; k0 < nt; k0 += 4) { f32x2 ab[4];
#pragma unroll
            for (int k = 0; k < 4; ++k) { const int tt = t0 + (dir ? nt - 1 - (k0 + k) : k0 + k); ab[k] = *(const f32x2*)(AGG + 2 * (((size_t)dir * 640 + tt) * 512 + ch)); }
#pragma unroll
            for (int k = 0; k < 4; ++k) { const int tt = t0 + (dir ? nt - 1 - (k0 + k) : k0 + k); CIN[((size_t)dir * 640 + tt) * 512 + ch] = h; h = ab[k][0] * h + ab[k][1]; } }
        if (ctx) p.out[OUT_LRU + (((size_t)seq * 2 + l) * 2 + dir) * 512 + ch] = h;
    }
}
__device__ __forceinline__ void attn_tile(const LAS bf16_t* Kb, const LAS bf16_t* Vb, const bf16x8 (&qf)[2][2], f32x4 (&o)[4][2], float (&mrun)[2], float (&lrun)[2], const bool masked, const int key0, const int qw, const int fr, const int fq, const int lane) {
    f32x4 s[2][4];
#pragma unroll
    for (int m = 0; m < 2; ++m)
#pragma unroll
        for (int n = 0; n < 4; ++n) s[m][n] = (f32x4){0.f, 0.f, 0.f, 0.f};
#pragma unroll
    for (int n = 0; n < 4; ++n)
#pragma unroll
        for (int kk = 0; kk < 2; ++kk) { const bf16x8 kf = *(const LAS bf16x8*)(Kb + (16 * n + fr) * 72 + 32 * kk + 8 * fq);
#pragma unroll
            for (int m = 0; m < 2; ++m) s[m][n] = __builtin_amdgcn_mfma_f32_16x16x32_bf16(kf, qf[m][kk], s[m][n], 0, 0, 0); }
    if (masked) {
#pragma unroll
        for (int m = 0; m < 2; ++m) { const int q = qw + 16 * m + fr;
#pragma unroll
            for (int n = 0; n < 4; ++n)
#pragma unroll
                for (int j = 0; j < 4; ++j) { const int dk = key0 + 16 * n + 4 * fq + j - q; if (dk > 128 || dk < -128) s[m][n][j] = -1e30f; } }
    }
    bf16x8 pf[2][2];
#pragma unroll
    for (int m = 0; m < 2; ++m) {
        float mx = s[m][0][0];
#pragma unroll
        for (int n = 0; n < 4; ++n)
#pragma unroll
            for (int j = 0; j < 4; ++j) mx = fmaxf(mx, s[m][n][j]);
        mx = fmaxf(mx, shx(mx, 16, lane)); mx = fmaxf(mx, shx(mx, 32, lane));
        const float mn = fmaxf(mrun[m], mx), al = __builtin_amdgcn_exp2f(mrun[m] - mn); mrun[m] = mn;
        float ps = 0.f;
#pragma unroll
        for (int n = 0; n < 4; ++n)
#pragma unroll
            for (int j = 0; j < 4; ++j) { const float e = __builtin_amdgcn_exp2f(s[m][n][j] - mn); s[m][n][j] = e; ps += e; }
        lrun[m] = lrun[m] * al + ps;
        if (__any(al < 1.0f)) {
#pragma unroll
            for (int db = 0; db < 4; ++db) o[db][m] = o[db][m] * al;
        }
#pragma unroll
        for (int kk = 0; kk < 2; ++kk) { const u32x4 w = pack8(s[m][2 * kk], s[m][2 * kk + 1]); pf[m][kk] = __builtin_bit_cast(bf16x8, w); }
    }
#pragma unroll
    for (int db = 0; db < 4; ++db)
#pragma unroll
        for (int kk = 0; kk < 2; ++kk) {
            const u32x2 v0 = *(const LAS u32x2*)(Vb + (16 * db + fr) * 72 + 32 * kk + 4 * fq), v1 = *(const LAS u32x2*)(Vb + (16 * db + fr) * 72 + 32 * kk + 16 + 4 * fq);
            const u32x4 vw = {v0.x, v0.y, v1.x, v1.y}; const bf16x8 vf = __builtin_bit_cast(bf16x8, vw);
#pragma unroll
            for (int m = 0; m < 2; ++m) o[db][m] = __builtin_amdgcn_mfma_f32_16x16x32_bf16(vf, pf[m][kk], o[db][m], 0, 0, 0);
        }
}
__device__ __forceinline__ void attn_unit(CParams& p, int l, int unit, LAS unsigned char* lds, bf16_t* odst) {
    const int tid = pg8::opaque_tid(), lane = tid & 63, wave = tid >> 6, fr = lane & 15, fq = lane >> 4;
    int seq, hp, qb, T, rowbase; bool lat;
    if (unit < 1024) { lat = true; seq = unit >> 7; hp = (unit >> 5) & 3; qb = unit & 31; T = 4096; rowbase = MCTX + seq * 4096; }
    else { const int u2 = unit - 1024; lat = false; seq = u2 >> 3; hp = (u2 >> 1) & 3; qb = u2 & 1; T = 256; rowbase = seq * 256; }
    const int kvh = hp >> 1, head = hp * 2 + (wave >> 2), q0 = qb * 128, qw = q0 + 32 * (wave & 3);
    int kstart, nloc;
    if (lat) { kstart = q0 - 128 < 0 ? 0 : q0 - 128; const int kend = q0 + 256 > T ? T : q0 + 256; nloc = (kend - kstart) >> 6; } else { kstart = 0; nloc = 4; }
    const int ntile = lat ? nloc + 8 : nloc;
    bf16_t* QB = (bf16_t*)(p.ws + WS_QB);
    const bf16_t* KB = (const bf16_t*)(p.ws + WS_KB); const bf16_t* VT = (const bf16_t*)(p.ws + WS_VT);
    const bf16_t* CK = (const bf16_t*)(p.ws + WS_CK); const bf16_t* CVT = (const bf16_t*)(p.ws + WS_CVT);
    LAS bf16_t* Kl = (LAS bf16_t*)lds;
    LAS bf16_t* Vl = (LAS bf16_t*)(lds + 18432);
    const int lr = tid >> 3, lc = (tid & 7) * 8;
#define ATT_LOAD(tix) do { if ((tix) < nloc) { const int key0 = kstart + 64 * (tix); \
            kreg = *(const u32x4*)(KB + (size_t)(rowbase + key0 + lr) * 128 + kvh * 64 + lc); vreg = *(const u32x4*)(VT + (size_t)(kvh * 64 + lr) * M + rowbase + key0 + lc); } \
        else { const int c_ = (tix) - nloc; kreg = *(const u32x4*)(CK + (((size_t)seq * 2 + kvh) * 512 + 64 * c_ + lr) * 64 + lc); vreg = *(const u32x4*)(CVT + (((size_t)seq * 2 + kvh) * 64 + lr) * 512 + 64 * c_ + lc); } } while (0)
#define ATT_STORE(buf) do { *(LAS u32x4*)(Kl + (buf) * 4608 + lr * 72 + lc) = kreg; *(LAS u32x4*)(Vl + (buf) * 4608 + lr * 72 + lc) = vreg; } while (0)
    u32x4 kreg, vreg, kreg2, vreg2;
#define ATT_LOAD2(tix) do { if ((tix) < nloc) { const int key0 = kstart + 64 * (tix); \
            kreg2 = *(const u32x4*)(KB + (size_t)(rowbase + key0 + lr) * 128 + kvh * 64 + lc); vreg2 = *(const u32x4*)(VT + (size_t)(kvh * 64 + lr) * M + rowbase + key0 + lc); } \
        else { const int c_ = (tix) - nloc; kreg2 = *(const u32x4*)(CK + (((size_t)seq * 2 + kvh) * 512 + 64 * c_ + lr) * 64 + lc); vreg2 = *(const u32x4*)(CVT + (((size_t)seq * 2 + kvh) * 64 + lr) * 512 + 64 * c_ + lc); } } while (0)
#define ATT_STORE2(buf) do { *(LAS u32x4*)(Kl + (buf) * 4608 + lr * 72 + lc) = kreg2; *(LAS u32x4*)(Vl + (buf) * 4608 + lr * 72 + lc) = vreg2; } while (0)
    ATT_LOAD(0);
    if (1 < ntile) ATT_LOAD2(1);
    bf16x8 qf[2][2];
#pragma unroll
    for (int m = 0; m < 2; ++m)
#pragma unroll
        for (int kk = 0; kk < 2; ++kk) qf[m][kk] = *(const bf16x8*)(QB + (size_t)(rowbase + qw + 16 * m + fr) * 512 + head * 64 + 32 * kk + 8 * fq);
    const float sink2 = p.in[32][l * 8 + head] * LOG2E;
    float mrun[2] = {sink2, sink2}, lrun[2] = {fq == 0 ? 1.f : 0.f, fq == 0 ? 1.f : 0.f};
    f32x4 o[4][2];
#pragma unroll
    for (int db = 0; db < 4; ++db)
#pragma unroll
        for (int m = 0; m < 2; ++m) o[db][m] = (f32x4){0.f, 0.f, 0.f, 0.f};
    ATT_STORE(0);
    __syncthreads();
    for (int tix = 0; tix < ntile; tix += 2) {
        if (tix + 2 < ntile) ATT_LOAD(tix + 2);
        { const bool loc_ = lat && tix < nloc; const int k0_ = kstart + 64 * tix;
          if (!(loc_ && (k0_ > qw + 159 || k0_ + 63 < qw - 128))) attn_tile(Kl, Vl, qf, o, mrun, lrun, loc_, k0_, qw, fr, fq, lane); }
        if (tix + 1 < ntile) ATT_STORE2(1);
        __syncthreads();
        if (tix + 1 < ntile) {
            if (tix + 3 < ntile) ATT_LOAD2(tix + 3);
            { const bool loc_ = lat && tix + 1 < nloc; const int k0_ = kstart + 64 * (tix + 1);
              if (!(loc_ && (k0_ > qw + 159 || k0_ + 63 < qw - 128))) attn_tile(Kl + 4608, Vl + 4608, qf, o, mrun, lrun, loc_, k0_, qw, fr, fq, lane); }
            if (tix + 2 < ntile) ATT_STORE(0);
            __syncthreads();
        }
    }
#pragma unroll
    for (int m = 0; m < 2; ++m) {
        float lt = lrun[m]; lt += shx(lt, 16, lane); lt += shx(lt, 32, lane);
        const float inv = 1.0f / lt;
        bf16_t* op = odst + (size_t)(rowbase + qw + 16 * m + fr) * 512 + head * 64 + 4 * fq;
#pragma unroll
        for (int db = 0; db < 4; ++db) *(u32x2*)(op + 16 * db) = pack4(o[db][m] * inv);
    }
#undef ATT_LOAD
#undef ATT_STORE
#undef ATT_LOAD2
#undef ATT_STORE2
}
struct OneUnit { int pm, pn;
    __device__ bool next(int i, Unit& u) const { if (i) return false; u.pm = pm; u.pn = pn; return true; }
    __device__ __forceinline__ void a_ready(const Unit&) const {}
    __device__ __forceinline__ void done(const Unit&) const {} };
struct PanelOrder { int pm;
    __device__ bool next(int i, Unit& u) const { if (i >= 4) return false; u.pm = pm; u.pn = i; return true; }
    __device__ __forceinline__ void a_ready(const Unit&) const {}
    __device__ __forceinline__ void done(const Unit&) const {} };
__device__ __forceinline__ void gemm_n1024_full(LAS unsigned char* lds, const bf16_t* A, const bf16_t* Bt, const int K, bf16_t* O, const int Gs, const int cs) {
    pg8::Gemm g{A, Bt, MSPLIT, D, K, K, K}; pg8::Order S; S.init(MSPLIT, D, Gs, cs); EpiPlain E{O, D}; pg8::gemm_phase<EpiPlain, pg8::Order, true, true>(lds, g, S, E);
}
__device__ __forceinline__ void gemm_n1024_halves(LAS unsigned char* lds, const bf16_t* A, const bf16_t* Bt, const int K, bf16_t* O, bf16_t* O2, const int G, const int bx) {
    for (int u = bx; u < 256; u += G) { const int t = u >> 1, kh = u & 1, Kh = K >> 1;
        pg8::Gemm g{A + kh * Kh, Bt + kh * Kh, M, D, Kh, K, K}; OneUnit S{128 + (t >> 2), t & 3}; EpiPlain E{kh ? O2 - (size_t)MSPLIT * D : O, D};
        pg8::gemm_phase<EpiPlain, OneUnit, true, true>(lds, g, S, E); }
}
__device__ __forceinline__ void gemm_n1024_splitk(LAS unsigned char* lds, const bf16_t* A, const bf16_t* Bt, const int K, bf16_t* O, bf16_t* O2, const int G, const int bx) {
    gemm_n1024_full(lds, A, Bt, K, O, G, bx); gemm_n1024_halves(lds, A, Bt, K, O, O2, G, bx);
}
template <class Sched> __device__ __forceinline__ void merge_chain(LAS unsigned char* lds, unsigned char* ws, const bf16_t* H, pg8::u32x4* scr, const Sched& S) {
    const bf16_t* WIN = (const bf16_t*)(ws + WS_WIN); bf16_t* MG = (bf16_t*)(ws + WS_MERGED);
    { pg8::Gemm g{H, WIN + (size_t)2304 * D, M, D, D, D, D}; EpiMerge<0> E{scr, MG}; pg8::gemm_phase<EpiMerge<0>, Sched, true, true>(lds, g, S, E); }
    { pg8::Gemm g{(const bf16_t*)(ws + WS_YL), (const bf16_t*)(ws + WS_WOL), M, D, 512, 512, 512}; EpiMerge<1> E{scr, MG}; pg8::gemm_phase<EpiMerge<1>, Sched, true, true>(lds, g, S, E); }
    { pg8::Gemm g{H, WIN + (size_t)3328 * D, M, D, D, D, D}; EpiMerge<0> E{scr, MG}; pg8::gemm_phase<EpiMerge<0>, Sched, true, true>(lds, g, S, E); }
    { pg8::Gemm g{(const bf16_t*)(ws + WS_S5Y), (const bf16_t*)(ws + WS_WGLU), M, D, 512, 512, 512}; EpiMerge<2> E{scr, MG}; pg8::gemm_phase<EpiMerge<2>, Sched, true, true>(lds, g, S, E); }
    { pg8::Gemm g{(const bf16_t*)(ws + WS_S5Y), (const bf16_t*)(ws + WS_WGLU) + (size_t)1024 * 512, M, D, 512, 512, 512}; EpiMerge<3> E{scr, MG}; pg8::gemm_phase<EpiMerge<3>, Sched, true, true>(lds, g, S, E); }
    { pg8::Gemm g{H, WIN + (size_t)4352 * D, M, D, D, D, D}; EpiMerge<0> E{scr, MG}; pg8::gemm_phase<EpiMerge<0>, Sched, true, true>(lds, g, S, E); }
    { pg8::Gemm g{(const bf16_t*)(ws + WS_QB), (const bf16_t*)(ws + WS_WOA), M, D, 512, 512, 512}; EpiMerge<4> E{scr, MG}; pg8::gemm_phase<EpiMerge<4>, Sched, true, true>(lds, g, S, E); }
}
constexpr int NPHASE = 29;
#ifndef ONLY_K
#define ONLY_K -1
#endif
#define EN(n) (ONLY_K < 0 || ONLY_K == (n) || ONLY_K / 10 == (n))
#define SUB(j) (ONLY_K < 20 || ONLY_K % 10 == (j))
#ifndef MK_SPLIT
#define MK_SPLIT 0
#endif
constexpr int REPS[14] = {1, 1, 1, 1, 1, 1, 1, 1, 1, 1, 1, 1, 1, 1};
constexpr int EXTRA_SYNCS = 0;
constexpr bool PROBE_ATT = false, PROBE_MIXB = false;
#define PH_ON(q) (ph_lo <= (q) && (q) < ph_hi)
template <int l> __device__ __forceinline__ void run_layer(CParams* kp, const int ph_lo, const int ph_hi, LAS unsigned char* lds, cg::grid_group& grid, const XcdBarrier& xbar) {
    if (PH_ON(14 * l + 0)) {
      _Pragma("unroll") for (int rep = 0; rep < REPS[0]; ++rep) { if (rep) xcd_barrier(xbar);
        { CParams* kq = kp; asm volatile("" : "+s"(kq)); CParams& p = *kq; unsigned char* ws = p.ws; (void)ws;
          int G = gridDim.x, bx = blockIdx.x; asm volatile("" : "+s"(G), "+s"(bx));
          bf16_t* H = (bf16_t*)(ws + WS_H); bf16_t* F = (bf16_t*)(ws + WS_F); (void)H; (void)F;
          prep_phase(p, l, lds, G, bx);
        } }
        if (14 * l + 0 + 1 < ph_hi) { if (l == 0 && ph_hi < 0) grid.sync();
                                      xcd_barrier(xbar); }
    }
    if (PH_ON(14 * l + 1)) {
      _Pragma("unroll") for (int rep = 0; rep < REPS[1]; ++rep) { if (rep) xcd_barrier(xbar);
        { CParams* kq = kp; asm volatile("" : "+s"(kq)); CParams& p = *kq; unsigned char* ws = p.ws; (void)ws;
          int G = gridDim.x, bx = blockIdx.x; asm volatile("" : "+s"(G), "+s"(bx));
          bf16_t* H = (bf16_t*)(ws + WS_H); bf16_t* F = (bf16_t*)(ws + WS_F); (void)H; (void)F;
          prep2_phase(p, l, G, bx); row_phase(p, l, 0, G, bx);
        } }
        if (14 * l + 1 + 1 < ph_hi) xcd_barrier(xbar);
    }
    if (PH_ON(14 * l + 2)) {
      _Pragma("unroll") for (int rep = 0; rep < REPS[2]; ++rep) { if (rep) xcd_barrier(xbar);
        { CParams* kq = kp; asm volatile("" : "+s"(kq)); CParams& p = *kq; unsigned char* ws = p.ws; (void)ws;
          int G = gridDim.x, bx = blockIdx.x; asm volatile("" : "+s"(G), "+s"(bx));
          bf16_t* H = (bf16_t*)(ws + WS_H); bf16_t* F = (bf16_t*)(ws + WS_F); (void)H; (void)F;
          {
            pg8::Gemm g{H, (const bf16_t*)(ws + WS_WGU0), M, 2 * FF, D, D, D}; pg8::Order S; S.init(M, 2 * FF, G, bx);
            EpiSwiGLU E{(bf16_t*)(ws + WS_ACT)};
            pg8::gemm_phase<EpiSwiGLU, pg8::Order, true, true>(lds, g, S, E);
        }
        } }
        if (14 * l + 2 + 1 < ph_hi) xcd_barrier(xbar);
    }
    if (PH_ON(14 * l + 3)) {
      _Pragma("unroll") for (int rep = 0; rep < REPS[3]; ++rep) { if (rep) xcd_barrier(xbar);
        { CParams* kq = kp; asm volatile("" : "+s"(kq)); CParams& p = *kq; unsigned char* ws = p.ws; (void)ws;
          int G = gridDim.x, bx = blockIdx.x; asm volatile("" : "+s"(G), "+s"(bx));
          bf16_t* H = (bf16_t*)(ws + WS_H); bf16_t* F = (bf16_t*)(ws + WS_F); (void)H; (void)F;
          {
            gemm_n1024_splitk(lds, (const bf16_t*)(ws + WS_ACT), (const bf16_t*)(ws + WS_WD0), FF, F, (bf16_t*)(ws + WS_F2), G, bx);
        }
        } }
        if (14 * l + 3 + 1 < ph_hi) xcd_barrier(xbar);
    }
    if (PH_ON(14 * l + 4)) {
      _Pragma("unroll") for (int rep = 0; rep < REPS[4]; ++rep) { if (rep) xcd_barrier(xbar);
        { CParams* kq = kp; asm volatile("" : "+s"(kq)); CParams& p = *kq; unsigned char* ws = p.ws; (void)ws;
          int G = gridDim.x, bx = blockIdx.x; asm volatile("" : "+s"(G), "+s"(bx));
          bf16_t* H = (bf16_t*)(ws + WS_H); bf16_t* F = (bf16_t*)(ws + WS_F); (void)H; (void)F;
          row_phase(p, l, 1, G, bx);
        } }
        if (14 * l + 4 + 1 < ph_hi) xcd_barrier(xbar);
    }
    if (PH_ON(14 * l + 5)) {
      _Pragma("unroll") for (int rep = 0; rep < REPS[5]; ++rep) { if (rep) xcd_barrier(xbar);
        { CParams* kq = kp; asm volatile("" : "+s"(kq)); CParams& p = *kq; unsigned char* ws = p.ws; (void)ws;
          int G = gridDim.x, bx = blockIdx.x; asm volatile("" : "+s"(G), "+s"(bx));
          bf16_t* H = (bf16_t*)(ws + WS_H); bf16_t* F = (bf16_t*)(ws + WS_F); (void)H; (void)F;
          {
            pg8::Gemm g{H, (const bf16_t*)(ws + WS_WIN), M, NIN, D, D, D}; pg8::Order S; S.init(M, NIN, G, bx);
            EpiIn E{(bf16_t*)(ws + WS_QB), (bf16_t*)(ws + WS_KB), (bf16_t*)(ws + WS_VT), (bf16_t*)(ws + WS_XL), (bf16_t*)(ws + WS_YL), (bf16_t*)(ws + WS_UH), p.out, (const float*)(ws + WS_ROPE), l};
            pg8::gemm_phase<EpiIn, pg8::Order, true, true>(lds, g, S, E);
        }
        } }
        if (14 * l + 5 + 1 < ph_hi) xcd_barrier(xbar);
    }
    if (PH_ON(14 * l + 6)) {
      _Pragma("unroll") for (int rep = 0; rep < REPS[6]; ++rep) { if (rep) xcd_barrier(xbar);
        { CParams* kq = kp; asm volatile("" : "+s"(kq)); CParams& p = *kq; unsigned char* ws = p.ws; (void)ws;
          int G = gridDim.x, bx = blockIdx.x; asm volatile("" : "+s"(G), "+s"(bx));
          bf16_t* H = (bf16_t*)(ws + WS_H); bf16_t* F = (bf16_t*)(ws + WS_F); (void)H; (void)F;
          {
            if (SUB(0)) for (int r = 0; r < 2; ++r) {
                pg8::Gemm g{(const bf16_t*)(ws + WS_UH), (const bf16_t*)(ws + WS_PT), 32 * NCHUNK, 256, 256, 512, 256}; pg8::Order S; S.init(32 * NCHUNK, 256, G, bx, r, 1, 10);
                EpiS5State E{(bf16_t*)(ws + WS_UH), (const float*)(ws + WS_APOW), p.in[6], p.out, l};
                pg8::gemm_phase<EpiS5State, pg8::Order, false, true>(lds, g, S, E);
                __syncthreads();
            }
            if (SUB(1)) lru_pass<1>(p, l, lds, G, bx, nullptr);
        }
        } }
        if (14 * l + 6 + 1 < ph_hi) xcd_barrier(xbar);
    }
    if (PH_ON(14 * l + 7)) {
      _Pragma("unroll") for (int rep = 0; rep < REPS[7]; ++rep) { if (rep) xcd_barrier(xbar);
        { CParams* kq = kp; asm volatile("" : "+s"(kq)); CParams& p = *kq; unsigned char* ws = p.ws; (void)ws;
          int G = gridDim.x, bx = blockIdx.x; asm volatile("" : "+s"(G), "+s"(bx));
          bf16_t* H = (bf16_t*)(ws + WS_H); bf16_t* F = (bf16_t*)(ws + WS_F); (void)H; (void)F;
          {
            lru_carry(p, l, G, bx);
            if (PROBE_ATT) { for (int u = bx; u < 1280; u += G) attn_unit(p, l, u, lds, (bf16_t*)(ws + WS_S5Y)); }
            for (int u = bx; u < 1280; u += G) attn_unit(p, l, u, lds, (bf16_t*)(ws + WS_QB));
        }
        } }
        if (14 * l + 7 + 1 < ph_hi) xcd_barrier(xbar);
    }
    if (PH_ON(14 * l + 8)) {
      _Pragma("unroll") for (int rep = 0; rep < REPS[8]; ++rep) { if (rep) xcd_barrier(xbar);
        { CParams* kq = kp; asm volatile("" : "+s"(kq)); CParams& p = *kq; unsigned char* ws = p.ws; (void)ws;
          int G = gridDim.x, bx = blockIdx.x; asm volatile("" : "+s"(G), "+s"(bx));
          bf16_t* H = (bf16_t*)(ws + WS_H); bf16_t* F = (bf16_t*)(ws + WS_F); (void)H; (void)F;
          {
            if (PROBE_MIXB) { lru_pass<3>(p, l, lds, G, bx, (bf16_t*)(ws + WS_F + 40 * MiB)); }
            lru_pass<3>(p, l, lds, G, bx, (bf16_t*)(ws + WS_YL));
            if (SUB(0)) {
            pg8::Gemm g{(const bf16_t*)(ws + WS_UH), (const bf16_t*)(ws + WS_TT), 32 * NCHUNK, 256, 512, 512, 512}; pg8::Order S; S.init(32 * NCHUNK, 256, G, bx, 0, 1 << 30, 10);
            EpiS5Out E{(const bf16_t*)(ws + WS_UH), (bf16_t*)(ws + WS_S5Y), p.in[30] + (size_t)l * 512};
            pg8::gemm_phase<EpiS5Out, pg8::Order, true, true>(lds, g, S, E); }
        }
        } }
        if (14 * l + 8 + 1 < ph_hi) xcd_barrier(xbar);
    }
    if (PH_ON(14 * l + 9)) {
      _Pragma("unroll") for (int rep = 0; rep < REPS[9]; ++rep) { if (rep) xcd_barrier(xbar);
        { CParams* kq = kp; asm volatile("" : "+s"(kq)); CParams& p = *kq; unsigned char* ws = p.ws; (void)ws;
          int G = gridDim.x, bx = blockIdx.x; asm volatile("" : "+s"(G), "+s"(bx));
          bf16_t* H = (bf16_t*)(ws + WS_H); bf16_t* F = (bf16_t*)(ws + WS_F); (void)H; (void)F;
          {
            pg8::u32x4* scr = (pg8::u32x4*)(ws + WS_SCR) + (size_t)bx * 16384;
            const int nr = (G == 256) ? 2 : 3, mrows = (G == 256) ? MSPLIT : M;
            for (int r = 0; r < nr; ++r) { pg8::Order S; S.init(mrows, D, G, bx, r, 1); merge_chain<pg8::Order>(lds, ws, H, scr, S); }
          }
        } }
        if (14 * l + 9 + 1 < ph_hi) xcd_barrier(xbar);
    }
    if (PH_ON(14 * l + 10)) {
      _Pragma("unroll") for (int rep = 0; rep < REPS[10]; ++rep) { if (rep) xcd_barrier(xbar);
        { CParams* kq = kp; asm volatile("" : "+s"(kq)); CParams& p = *kq; unsigned char* ws = p.ws; (void)ws;
          int G = gridDim.x, bx = blockIdx.x; asm volatile("" : "+s"(G), "+s"(bx));
          bf16_t* H = (bf16_t*)(ws + WS_H); bf16_t* F = (bf16_t*)(ws + WS_F); (void)H; (void)F;
          {
            const bf16_t* MGc = (const bf16_t*)(ws + WS_MERGED); const bf16_t* WO = (const bf16_t*)(ws + WS_WOUT);
            if (G == 256) {
                if (bx < 128) { pg8::u32x4* scr = (pg8::u32x4*)(ws + WS_SCR) + (size_t)bx * 16384; OneUnit S{128 + (bx >> 2), bx & 3}; merge_chain<OneUnit>(lds, ws, H, scr, S); }
                else {
                    pg8::Gemm g{MGc, WO, MSPLIT, D, D, D, D}; PanelOrder S{bx - 128}; EpiPlain E{H, D}; pg8::gemm_phase<EpiPlain, PanelOrder, true, true>(lds, g, S, E);
                    asm volatile("s_waitcnt vmcnt(0)" ::: "memory"); __syncthreads();
                    row_phase(p, l, 2, 1, 0, (bx - 128) * 256, (bx - 128) * 256 + 256);
                }
                xcd_barrier(xbar);
                gemm_n1024_halves(lds, MGc, WO, D, H, (bf16_t*)(ws + WS_F2), G, bx);
            } else gemm_n1024_splitk(lds, MGc, WO, D, H, (bf16_t*)(ws + WS_F2), G, bx);
        }
        } }
        if (14 * l + 10 + 1 < ph_hi) xcd_barrier(xbar);
    }
    if (PH_ON(14 * l + 11)) {
      _Pragma("unroll") for (int rep = 0; rep < REPS[11]; ++rep) { if (rep) xcd_barrier(xbar);
        { CParams* kq = kp; asm volatile("" : "+s"(kq)); CParams& p = *kq; unsigned char* ws = p.ws; (void)ws;
          int G = gridDim.x, bx = blockIdx.x; asm volatile("" : "+s"(G), "+s"(bx));
          bf16_t* H = (bf16_t*)(ws + WS_H); bf16_t* F = (bf16_t*)(ws + WS_F); (void)H; (void)F;
          if (G == 256) row_phase(p, l, 2, G, bx, MSPLIT, M); else row_phase(p, l, 2, G, bx);
        } }
        if (14 * l + 11 + 1 < ph_hi) xcd_barrier(xbar);
    }
    if (PH_ON(14 * l + 12)) {
      _Pragma("unroll") for (int rep = 0; rep < REPS[12]; ++rep) { if (rep) xcd_barrier(xbar);
        { CParams* kq = kp; asm volatile("" : "+s"(kq)); CParams& p = *kq; unsigned char* ws = p.ws; (void)ws;
          int G = gridDim.x, bx = blockIdx.x; asm volatile("" : "+s"(G), "+s"(bx));
          bf16_t* H = (bf16_t*)(ws + WS_H); bf16_t* F = (bf16_t*)(ws + WS_F); (void)H; (void)F;
          {
            pg8::Gemm g{H, (const bf16_t*)(ws + WS_WGU1), M, 2 * FF, D, D, D}; pg8::Order S; S.init(M, 2 * FF, G, bx);
            EpiSwiGLU E{(bf16_t*)(ws + WS_ACT)};
            pg8::gemm_phase<EpiSwiGLU, pg8::Order, true, true>(lds, g, S, E);
        }
        } }
        if (14 * l + 12 + 1 < ph_hi) xcd_barrier(xbar);
    }
    if (PH_ON(14 * l + 13)) {
      _Pragma("unroll") for (int rep = 0; rep < REPS[13]; ++rep) { if (rep) xcd_barrier(xbar);
        { CParams* kq = kp; asm volatile("" : "+s"(kq)); CParams& p = *kq; unsigned char* ws = p.ws; (void)ws;
          int G = gridDim.x, bx = blockIdx.x; asm volatile("" : "+s"(G), "+s"(bx));
          bf16_t* H = (bf16_t*)(ws + WS_H); bf16_t* F = (bf16_t*)(ws + WS_F); (void)H; (void)F;
          {
            gemm_n1024_splitk(lds, (const bf16_t*)(ws + WS_ACT), (const bf16_t*)(ws + WS_WD1), FF, F, (bf16_t*)(ws + WS_F2), G, bx);
        }
        } }
        if (14 * l + 13 + 1 < ph_hi) xcd_barrier(xbar);
    }
}
__global__ void __launch_bounds__(NT, 2) fwd_kernel(Params p_unused) {
    extern __shared__ __attribute__((aligned(16))) unsigned char lds_raw[];
    LAS unsigned char* lds = (LAS unsigned char*)lds_raw;
    cg::grid_group grid = cg::this_grid();
    CParams* kp = (CParams*)__builtin_amdgcn_kernarg_segment_ptr();
    const int ph_lo = kp->ph_lo, ph_hi = kp->ph_hi;
    volatile LAS unsigned* misc = (volatile LAS unsigned*)(lds + MISC_OFF);
    if (threadIdx.x < 16) misc[threadIdx.x] = 0u;
    __syncthreads();
    XcdBarrier xbar; xbar.bar = (unsigned*)kp->ws + 1024; xbar.x = 0; xbar.st = nullptr;
    if (ph_hi - ph_lo > 1) xbar = xcd_barrier_post((unsigned*)kp->ws + 1024, misc + 8);
    run_layer<0>(kp, ph_lo, ph_hi, lds, grid, xbar);
    run_layer<1>(kp, ph_lo, ph_hi, lds, grid, xbar);
    for (int e = 0; e < EXTRA_SYNCS; ++e) xcd_barrier(xbar);
    if (PH_ON(28)) { CParams* kq = kp; asm volatile("" : "+s"(kq)); CParams& p = *kq; int G = gridDim.x, bx = blockIdx.x; asm volatile("" : "+s"(G), "+s"(bx)); row_phase(p, 1, 3, G, bx); }
}

extern "C" void kernel_launch(void* const* d_in, const int* in_sizes, int n_in, void* d_out, int out_size, void* d_ws, size_t ws_size, hipStream_t stream) {
    static int grid = 0;
    if (grid == 0) {
        if (n_in != 36 || ws_size < WS_END) { fprintf(stderr, "kernel_launch: n_in %d ws %zu (need %zu)\n", n_in, ws_size, (size_t)WS_END); grid = -1; return; }
        int dev = 0, cus = 0, per_cu = 0;
        hipGetDevice(&dev); hipDeviceGetAttribute(&cus, hipDeviceAttributeMultiprocessorCount, dev);
        if (hipFuncSetAttribute((const void*)fwd_kernel, hipFuncAttributeMaxDynamicSharedMemorySize, LDS_BYTES) != hipSuccess) { fprintf(stderr, "kernel_launch: hipFuncSetAttribute failed\n"); grid = -1; return; }
        hipOccupancyMaxActiveBlocksPerMultiprocessor(&per_cu, (const void*)fwd_kernel, NT, LDS_BYTES);
        (void)hipGetLastError();
        if (per_cu < 1) per_cu = 1;
        grid = cus * 1;
    }
    if (grid < 0) return;
    if (hipMemsetAsync(d_ws, 0, 65536, stream) != hipSuccess) { fprintf(stderr, "kernel_launch: memset failed\n"); return; }
    Params p{};
    for (int i = 0; i < 36; ++i) p.in[i] = (const float*)d_in[i];
    p.out = (float*)d_out; p.ws = (unsigned char*)d_ws;
#if MK_SPLIT
    for (int ph = 0; ph < NPHASE; ++ph) { p.ph_lo = ph; p.ph_hi = ph + 1; void* args[] = {&p};
        hipError_t e = hipLaunchCooperativeKernel((const void*)fwd_kernel, dim3(grid), dim3(NT), args, LDS_BYTES, stream);
        if (e != hipSuccess) { fprintf(stderr, "launch %d failed: %s\n", ph, hipGetErrorString(e)); break; } }
#else
    p.ph_lo = 0; p.ph_hi = NPHASE; void* args[] = {&p};
    hipError_t e = hipLaunchCooperativeKernel((const void*)fwd_kernel, dim3(grid), dim3(NT), args, LDS_BYTES, stream);
    if (e != hipSuccess) fprintf(stderr, "cooperative launch failed: %s (grid %d)\n", hipGetErrorString(e), grid);
#endif
}
```

```cpp
#include <hip/hip_runtime.h>
#include <hip/hip_cooperative_groups.h>
#include <cstdio>
#include <cstdint>
namespace cg = cooperative_groups;
namespace pg8 {
#define PG8_LAS __attribute__((address_space(3)))
typedef unsigned short bf16_t;
typedef short bf16x8 __attribute__((ext_vector_type(8)));
typedef float f32x4 __attribute__((ext_vector_type(4)));
typedef unsigned u32x4 __attribute__((ext_vector_type(4)));
typedef unsigned u32x2 __attribute__((ext_vector_type(2)));
constexpr int BM = 256, BK = 64, HALF = 128, HTB = HALF * BK * 2, STAGE_BYTES = 8 * HTB, NXCD = 8, WGM = 8;
__host__ __device__ __forceinline__ int lds_byte(int r, int c) { const int st = (r >> 4) * 2 + (c >> 5), rr = r & 15, cc = c & 31, ob = rr * 64 + cc * 2; return st * 1024 + (ob ^ (((ob >> 9) & 1) << 5)); }
__host__ __device__ __forceinline__ void stage_rc(int b, int& R, int& C) { const int st = b / 1024, sb = b % 1024, swz = sb ^ (((sb >> 9) & 1) << 5); R = (st >> 1) * 16 + swz / 64; C = (st & 1) * 32 + (swz % 64) / 2; }
__host__ __device__ __forceinline__ int perm32(int rho) { const int n = rho >> 4, i = rho & 15; return 8 * (i >> 2) + 4 * n + (i & 3); }
__device__ __forceinline__ int opaque_tid() { int t = threadIdx.x; asm volatile("" : "+v"(t)); return t; }
struct Unit { int pm, pn; };
struct Gemm { const bf16_t* A; const bf16_t* Bt; int M, N, K, lda, ldb; };
struct Order {
    int nM, nN, nwg, G, c, i0, imax, batched;
    __device__ void init(int M, int N, int G_, int c_, int i0_ = 0, int imax_ = 1 << 30, int batched_ = 0) { nM = M / BM; nN = N / BM; nwg = batched_ ? nM : nM * nN; G = G_; c = c_; i0 = i0_; imax = imax_; batched = batched_; }
    __device__ bool next(int i, Unit& u) const {
        if (i >= imax) return false;
        const long L = (long)(i0 + i) * G + c; if (L >= nwg) return false;
        if (batched) { u.pm = (int)L; u.pn = (int)L / batched; return true; }
        int wgid = (int)L; { const int q = nwg / NXCD, r = nwg % NXCD, xcd = wgid % NXCD, off = wgid / NXCD; wgid = (xcd < r ? xcd * (q + 1) : r * (q + 1) + (xcd - r) * q) + off; }
        const int nig = WGM * nN, gid = wgid / nig, fm = gid * WGM, gsz = (nM - fm) < WGM ? (nM - fm) : WGM;
        u.pm = fm + ((wgid % nig) % gsz); u.pn = (wgid % nig) / gsz; return true;
    }
    __device__ __forceinline__ void a_ready(const Unit&) const {}
    __device__ __forceinline__ void done(const Unit&) const {}
};
__device__ __forceinline__ unsigned cvt_pk_bf16(float lo, float hi) { unsigned r; asm volatile("v_cvt_pk_bf16_f32 %0, %1, %2" : "=v"(r) : "v"(lo), "v"(hi)); return r; }
template <class Epi, class Sched, bool ALIGN_EPI = false, bool SP2 = false>
__device__ __forceinline__ void gemm_phase(PG8_LAS unsigned char* lds, const Gemm g, const Sched& S, const Epi& E) {
    const int tid = pg8::opaque_tid(), wid = __builtin_amdgcn_readfirstlane(tid >> 6), lane = tid & 63, wr = wid >> 2, wc = wid & 3, fr = lane & 15, fq = lane >> 4;
    const int K = g.K, nt = K / BK;
    unsigned voffA[2], voffB[2];
#pragma unroll
    for (int i = 0; i < 2; ++i) { int R, C; stage_rc(tid * 16 + i * 8192, R, C); const int Rb = Epi::PERM ? ((R & ~31) + perm32(R & 31)) : R;
        voffA[i] = (unsigned)(R * g.lda + C) * 2u; voffB[i] = (unsigned)(Rb * g.ldb + C) * 2u; }
    const size_t kstep = (size_t)(BK * 2);
    const size_t hstepA = (size_t)HALF * g.lda * 2, hstepB = (size_t)HALF * g.ldb * 2;
    const size_t tstepA = 2 * hstepA, tstepB = 2 * hstepB;
    const unsigned ldsw = (unsigned)wid * 1024u;
    const int aoff = lds_byte(wr * 64 + fr, fq * 8), boff = lds_byte(wc * 32 + fr, fq * 8);
#define PG8_SA(b, h) (((b) * 2 + (h)) * HTB)
#define PG8_SB(b, h) ((4 + (b) * 2 + (h)) * HTB)
#define PG8_STAGE(bufoff, gbase, voff) do { _Pragma("unroll") for (int _i = 0; _i < 2; ++_i) \
        __builtin_amdgcn_global_load_lds((const unsigned*)((const char*)(gbase) + (voff)[_i]), (PG8_LAS unsigned*)(lds + (bufoff) + ldsw + _i * 8192), 16, 0, 0); } while (0)
#define PG8_LDA(dst, b, h) do { _Pragma("unroll") for (int m = 0; m < 4; ++m) _Pragma("unroll") for (int k = 0; k < 2; ++k) dst[m][k] = *(const PG8_LAS bf16x8*)(lds + PG8_SA(b, h) + aoff + m * 2048 + k * 1024); } while (0)
#define PG8_LDB(dst, b, h) do { _Pragma("unroll") for (int n = 0; n < 2; ++n) _Pragma("unroll") for (int k = 0; k < 2; ++k) dst[n][k] = *(const PG8_LAS bf16x8*)(lds + PG8_SB(b, h) + boff + n * 2048 + k * 1024); } while (0)
#define PG8_MMA(ai, bj, At, Bt) do { __builtin_amdgcn_s_setprio(1); _Pragma("unroll") for (int m = 0; m < 4; ++m) _Pragma("unroll") for (int n = 0; n < 2; ++n) _Pragma("unroll") for (int k = 0; k < 2; ++k) \
        acc[ai][bj][m][n] = __builtin_amdgcn_mfma_f32_16x16x32_bf16(Bt[n][k], At[m][k], acc[ai][bj][m][n], 0, 0, 0); __builtin_amdgcn_s_setprio(0); } while (0)
#define PG8_WAIT_V(n) asm volatile("s_waitcnt vmcnt(" #n ")" ::: "memory")
#define PG8_WAIT_L(n) asm volatile("s_waitcnt lgkmcnt(" #n ")" ::: "memory")
#define PG8_BAR __builtin_amdgcn_s_barrier()
#define PG8_SCHED __builtin_amdgcn_sched_barrier(0)
    Unit cur, nxt; int ui = 0;
    if (!S.next(0, cur)) return;
    f32x4 acc[2][2][4][2];
#pragma unroll
    for (int a = 0; a < 2; ++a)
#pragma unroll
        for (int b = 0; b < 2; ++b)
#pragma unroll
            for (int m = 0; m < 4; ++m)
#pragma unroll
                for (int n = 0; n < 2; ++n) acc[a][b][m][n] = (f32x4){0.f, 0.f, 0.f, 0.f};
    bf16x8 At[4][2], B0[2][2], B1[2][2];
    const char* cA = (const char*)g.A + (size_t)cur.pm * tstepA; const char* cB = (const char*)g.Bt + (size_t)cur.pn * tstepB;
    S.a_ready(cur);
    if constexpr (SP2) {
        PG8_STAGE(PG8_SB(0, 0), cB, voffB); PG8_STAGE(PG8_SB(0, 1), cB + hstepB, voffB); PG8_STAGE(PG8_SA(0, 0), cA, voffA); PG8_STAGE(PG8_SA(0, 1), cA + hstepA, voffA);
        if (wr == 1) PG8_BAR;
        PG8_WAIT_V(2); PG8_BAR;
        PG8_STAGE(PG8_SB(1, 0), cB + kstep, voffB); PG8_STAGE(PG8_SA(1, 0), cA + kstep, voffA); PG8_STAGE(PG8_SB(1, 1), cB + hstepB + kstep, voffB);
        PG8_WAIT_V(6); PG8_BAR;
    } else {
        PG8_STAGE(PG8_SB(0, 0), cB, voffB); PG8_STAGE(PG8_SA(0, 0), cA, voffA); PG8_STAGE(PG8_SB(0, 1), cB + hstepB, voffB); PG8_STAGE(PG8_SA(0, 1), cA + hstepA, voffA);
        if (wr == 1) PG8_BAR;
        PG8_WAIT_V(4); PG8_BAR;
        PG8_STAGE(PG8_SB(1, 0), cB + kstep, voffB); PG8_STAGE(PG8_SA(1, 0), cA + kstep, voffA); PG8_STAGE(PG8_SB(1, 1), cB + hstepB + kstep, voffB);
        PG8_WAIT_V(6); PG8_BAR;
    }
    for (;;) {
        const bool has_next = S.next(ui + 1, nxt);
        const char* nA = has_next ? (const char*)g.A + (size_t)nxt.pm * tstepA : cA; const char* nB = has_next ? (const char*)g.Bt + (size_t)nxt.pn * tstepB : cB;
        for (int t = 0; t < nt; t += 2) {
            const bool last = (t == nt - 2);
            const char* a1 = cA + (size_t)(t + 1) * kstep;
            const char* a2 = last ? nA : cA + (size_t)(t + 2) * kstep; const char* b2 = last ? nB : cB + (size_t)(t + 2) * kstep;
            const char* a3 = a2 + kstep; const char* b3 = b2 + kstep;
            if (last && has_next) S.a_ready(nxt);
            if constexpr (SP2) {
            PG8_LDB(B0, 0, 0); PG8_LDB(B1, 0, 1); PG8_SCHED; PG8_LDA(At, 0, 0); PG8_STAGE(PG8_SA(1, 1), a1 + hstepA, voffA);
            PG8_WAIT_V(8); PG8_WAIT_L(0); PG8_BAR; PG8_MMA(0, 0, At, B0); PG8_MMA(0, 1, At, B1); PG8_BAR; PG8_SCHED;
            PG8_LDA(At, 0, 1); PG8_STAGE(PG8_SB(0, 0), b2, voffB); PG8_STAGE(PG8_SB(0, 1), b2 + hstepB, voffB); PG8_STAGE(PG8_SA(0, 0), a2, voffA);
            PG8_WAIT_V(8); PG8_WAIT_L(0); PG8_BAR; PG8_MMA(1, 0, At, B0); PG8_MMA(1, 1, At, B1); PG8_BAR; PG8_SCHED;
            PG8_LDB(B0, 1, 0); PG8_LDB(B1, 1, 1); PG8_SCHED; PG8_LDA(At, 1, 0); PG8_STAGE(PG8_SA(0, 1), a2 + hstepA, voffA);
            PG8_WAIT_V(8); PG8_WAIT_L(0); PG8_BAR; PG8_MMA(0, 0, At, B0); PG8_MMA(0, 1, At, B1); PG8_BAR; PG8_SCHED;
            PG8_LDA(At, 1, 1); PG8_STAGE(PG8_SB(1, 0), b3, voffB); PG8_STAGE(PG8_SB(1, 1), b3 + hstepB, voffB); PG8_STAGE(PG8_SA(1, 0), a3, voffA);
            PG8_WAIT_V(8); PG8_WAIT_L(0); PG8_BAR; PG8_MMA(1, 0, At, B0); PG8_MMA(1, 1, At, B1); PG8_BAR; PG8_SCHED;
            } else {
            PG8_LDB(B0, 0, 0); PG8_SCHED; PG8_LDA(At, 0, 0); PG8_STAGE(PG8_SA(1, 1), a1 + hstepA, voffA);
            PG8_WAIT_L(8); PG8_BAR; PG8_WAIT_L(0); PG8_MMA(0, 0, At, B0); PG8_BAR; PG8_SCHED;
            PG8_LDB(B1, 0, 1); PG8_STAGE(PG8_SB(0, 0), b2, voffB);
            PG8_BAR; PG8_WAIT_L(0); PG8_MMA(0, 1, At, B1); PG8_BAR;
            PG8_LDA(At, 0, 1); PG8_STAGE(PG8_SA(0, 0), a2, voffA);
            PG8_BAR; PG8_WAIT_L(0); PG8_MMA(1, 0, At, B0); PG8_BAR; PG8_SCHED;
            PG8_STAGE(PG8_SB(0, 1), b2 + hstepB, voffB);
            PG8_WAIT_V(6); PG8_BAR; PG8_MMA(1, 1, At, B1); PG8_BAR;
            PG8_LDB(B0, 1, 0); PG8_SCHED; PG8_LDA(At, 1, 0); PG8_STAGE(PG8_SA(0, 1), a2 + hstepA, voffA);
            PG8_WAIT_L(8); PG8_BAR; PG8_WAIT_L(0); PG8_MMA(0, 0, At, B0); PG8_BAR; PG8_SCHED;
            PG8_LDB(B1, 1, 1); PG8_STAGE(PG8_SB(1, 0), b3, voffB);
            PG8_BAR; PG8_WAIT_L(0); PG8_MMA(0, 1, At, B1); PG8_BAR;
            PG8_LDA(At, 1, 1); PG8_STAGE(PG8_SA(1, 0), a3, voffA);
            PG8_BAR; PG8_WAIT_L(0); PG8_MMA(1, 0, At, B0); PG8_BAR; PG8_SCHED;
            PG8_STAGE(PG8_SB(1, 1), b3 + hstepB, voffB);
            PG8_WAIT_V(6); PG8_BAR; PG8_MMA(1, 1, At, B1); PG8_BAR;
            }
        }
        if constexpr (ALIGN_EPI) { if (wr == 0) PG8_BAR; }
        if constexpr (!Epi::AFTER_DRAIN) { E(acc, cur, wr, wc, fr, fq); S.done(cur); }
        if (!has_next) break;
#pragma unroll
        for (int a = 0; a < 2; ++a)
#pragma unroll
            for (int b = 0; b < 2; ++b)
#pragma unroll
                for (int m = 0; m < 4; ++m)
#pragma unroll
                    for (int n = 0; n < 2; ++n) acc[a][b][m][n] = (f32x4){0.f, 0.f, 0.f, 0.f};
        cur = nxt; cA = nA; cB = nB; ++ui;
        if constexpr (ALIGN_EPI) { if (wr == 1) PG8_BAR; }
    }
    PG8_WAIT_V(0);
    if constexpr (!ALIGN_EPI) { if (wr == 0) PG8_BAR; }
    PG8_BAR;
    if constexpr (Epi::AFTER_DRAIN) { E.fused(acc, cur, wr, wc, fr, fq, lds, wid, lane); S.done(cur); }
#undef PG8_SA
#undef PG8_SB
#undef PG8_STAGE
#undef PG8_LDA
#undef PG8_LDB
#undef PG8_MMA
#undef PG8_WAIT_V
#undef PG8_WAIT_L
#undef PG8_BAR
#undef PG8_SCHED
}
}

using pg8::bf16_t; using pg8::f32x4; using pg8::u32x4; using pg8::u32x2; using pg8::bf16x8; using pg8::Unit; using pg8::cvt_pk_bf16;
#define LAS __attribute__((address_space(3)))
typedef float f32x2 __attribute__((ext_vector_type(2)));
constexpr int D = 1024, M = 40960, MCTX = 8192, FF = 2816, NIN = 2304, NT = 512, NWAVES = 8;
constexpr float LOG2E = 1.4426950408889634f, RMS_EPS = 1e-6f, QSCALE = 0.125f * 1.4426950408889634f;
constexpr size_t OUT_K = 41943040, OUT_V = 44040192, OUT_LRU = 46137344, OUT_SSM = 46202880;
constexpr int LDS_BYTES = 163840, MISC_OFF = 163840 - 256;
constexpr int NCHUNK = 2560;
constexpr size_t MiB = 1u << 20;
constexpr size_t WS_MOD = 1 * MiB, WS_ROPE = 2 * MiB, WS_APOW = 3 * MiB, WS_BBAR = 4 * MiB, WS_WL = 5 * MiB, WS_CK = 6 * MiB, WS_CVT = 7 * MiB, WS_AGG = 8 * MiB, WS_CIN = 13 * MiB,
    WS_TT = 16 * MiB, WS_PT = 24 * MiB, WS_WGU0 = 28 * MiB, WS_WGU1 = 39 * MiB, WS_WD0 = 50 * MiB, WS_WD1 = 50 * MiB + 5632 * 1024, WS_WIN = 61 * MiB, WS_WGLU = 61 * MiB + 10752 * 1024,
    WS_WOL = WS_WGLU + 2 * MiB, WS_WOA = WS_WOL + 1 * MiB, WS_WOUT = WS_WOA + 1 * MiB, WS_H = 78 * MiB, WS_F = 158 * MiB, WS_R = 238 * MiB, WS_F2 = 458 * MiB, WS_END = 474 * MiB;
constexpr int MSPLIT = 32768;
constexpr size_t WS_QB = WS_R, WS_YL = WS_R + 40 * MiB, WS_UH = WS_R + 80 * MiB, WS_S5Y = WS_R + 160 * MiB, WS_ACT = WS_R;
constexpr size_t WS_XL = WS_F, WS_KB = WS_F + 40 * MiB, WS_VT = WS_F + 50 * MiB, WS_MERGED = WS_F, WS_SCR = WS_UH;
static_assert(WS_WOUT + 2 * MiB <= WS_H, "ws map");

__device__ __forceinline__ float bf2f(unsigned h) { return __uint_as_float(h << 16); }
__device__ __forceinline__ float bflo(unsigned w) { return __uint_as_float(w << 16); }
__device__ __forceinline__ float bfhi(unsigned w) { return __uint_as_float(w & 0xffff0000u); }
__device__ __forceinline__ unsigned f2bf(float f) { unsigned u = __float_as_uint(f); return (u + 0x7fffu + ((u >> 16) & 1u)) >> 16; }
__device__ __forceinline__ float sigm(float x) { return 1.f / (1.f + __expf(-x)); }
__device__ __forceinline__ float sigm_f(float x) { return __builtin_amdgcn_rcpf(1.f + __builtin_amdgcn_exp2f(x * -1.4426950408889634f)); }
__device__ __forceinline__ float gelu_f(float x) { const float z = x * (1.0f + 0.044715f * x * x); return x * __builtin_amdgcn_rcpf(1.f + __builtin_amdgcn_exp2f(z * (-2.f * 0.7978845608028654f * 1.4426950408889634f))); }
__device__ __forceinline__ float gelu_t(float x) { const float z = 0.7978845608028654f * (x + 0.044715f * x * x * x); return x / (1.f + __expf(-2.f * z)); }
__device__ __forceinline__ float shx(float v, int mask, int lane) { return __int_as_float(__builtin_amdgcn_ds_bpermute((lane ^ mask) << 2, __float_as_int(v))); }
__device__ __forceinline__ float wave_sum(float v, int lane) {
#pragma unroll
    for (int o = 1; o < 64; o <<= 1) v += shx(v, o, lane);
    return v;
}
__device__ __forceinline__ u32x4 pack8(const f32x4 a, const f32x4 b) { u32x4 w; w.x = cvt_pk_bf16(a[0], a[1]); w.y = cvt_pk_bf16(a[2], a[3]); w.z = cvt_pk_bf16(b[0], b[1]); w.w = cvt_pk_bf16(b[2], b[3]); return w; }
__device__ __forceinline__ u32x2 pack4(const f32x4 a) { u32x2 w; w.x = cvt_pk_bf16(a[0], a[1]); w.y = cvt_pk_bf16(a[2], a[3]); return w; }

struct Params { const float* in[36]; float* out; unsigned char* ws; int ph_lo, ph_hi; };
typedef const __attribute__((address_space(4))) Params CParams;

#define XB_TMO      128
#define XB_XCNT(j)  (256  + 64 * (j))
#define XB_XSUB(j)  (1280 + 64 * (j))
#define XB_XGEN(j)  (2304 + 64 * (j))
#define XB_TOP      3328
#define XB_TOPGEN   3392
#define XCD_BAR_WORDS 3456
#define XB_SPIN_CAP (1u << 18)

__device__ __forceinline__ unsigned xb_ld(unsigned* p)              { return __hip_atomic_load(p, __ATOMIC_RELAXED, __HIP_MEMORY_SCOPE_AGENT); }
__device__ __forceinline__ unsigned xb_add(unsigned* p, unsigned v) { return __hip_atomic_fetch_add(p, v, __ATOMIC_RELAXED, __HIP_MEMORY_SCOPE_AGENT); }
__device__ __forceinline__ unsigned xb_xcc_id() { return (unsigned)__builtin_amdgcn_s_getreg((3 << 11) | 20) & 0xFu; }
#define XB_SPIN(cond, bar) do { unsigned _sp = 0; while (cond) { __builtin_amdgcn_s_sleep(1); \
    if ((++_sp & 255u) == 0u) { if (xb_ld(&(bar)[XB_TMO])) break; if (_sp > XB_SPIN_CAP) { atomicAdd(&(bar)[XB_TMO], 1u); break; } } } } while (0)

struct XcdBarrier {
    unsigned* bar; unsigned x;
    volatile LAS unsigned* st;
};

__device__ __forceinline__ XcdBarrier xcd_barrier_post(unsigned* bar, volatile LAS unsigned* st) {
    XcdBarrier b; b.bar = bar; b.x = xb_xcc_id(); b.st = st;
    if (threadIdx.x == 0) (void)xb_add(&bar[XB_XCNT(b.x)], 1u);
    return b;
}
__device__ __forceinline__ void xcd_barrier_complete(unsigned* bar, unsigned x, unsigned& nloc, unsigned& nx) {
    const unsigned G = gridDim.x * gridDim.y * gridDim.z;
    unsigned sum, cnt, mine, sp = 0u;
    for (;;) {
        sum = 0u; cnt = 0u; mine = 0u;
#pragma unroll
        for (unsigned j = 0; j < 16; ++j) { const unsigned c = xb_ld(&bar[XB_XCNT(j)]); sum += c; cnt += (c > 0u) ? 1u : 0u; mine = (j == x) ? c : mine; }
        if (sum == G) break;
        __builtin_amdgcn_s_sleep(1);
        if ((++sp & 255u) == 0u) { if (xb_ld(&bar[XB_TMO])) break; if (sp > XB_SPIN_CAP) { atomicAdd(&bar[XB_TMO], 1u); break; } }
    }
    nloc = mine > 0u ? mine : 1u; nx = cnt > 0u ? cnt : 1u;
}

__device__ __forceinline__ void xcd_barrier(const XcdBarrier& b) {
    asm volatile("s_waitcnt vmcnt(0)" ::: "memory");
    __syncthreads();
    if (threadIdx.x == 0) {
        unsigned* bar = b.bar;
        __builtin_amdgcn_s_waitcnt(0);
        unsigned nloc = b.st[0], nx = b.st[1];
        if (nloc == 0u) { xcd_barrier_complete(bar, b.x, nloc, nx); b.st[0] = nloc; b.st[1] = nx; }
        const unsigned old = xb_add(&bar[XB_XSUB(b.x)], 1u);
        const unsigned gen = old / nloc;
        if (old + 1u == (gen + 1u) * nloc) {
            __builtin_amdgcn_fence(__ATOMIC_RELEASE, "agent");
            asm volatile("s_waitcnt vmcnt(0)" ::: "memory");
            const unsigned og = xb_add(&bar[XB_TOP], 1u);
            const unsigned tg = og / nx;
            if (og + 1u == (tg + 1u) * nx) xb_add(&bar[XB_TOPGEN], 1u);
            else XB_SPIN(xb_ld(&bar[XB_TOPGEN]) == tg, bar);
            __builtin_amdgcn_fence(__ATOMIC_ACQUIRE, "agent");
            xb_add(&bar[XB_XGEN(b.x)], 1u);
            asm volatile("s_waitcnt vmcnt(0)" ::: "memory");
        } else {
            XB_SPIN(xb_ld(&bar[XB_XGEN(b.x)]) == gen, bar);
            __builtin_amdgcn_fence(__ATOMIC_ACQUIRE, "agent");
            asm volatile("s_waitcnt vmcnt(0)" ::: "memory");
        }
    }
    __syncthreads();
}

struct EpiPlain {
    static constexpr bool PERM = true, AFTER_DRAIN = false; bf16_t* O; int ldc;
    __device__ __forceinline__ void operator()(const f32x4 (&acc)[2][2][4][2], const Unit& u, int wr, int wc, int fr, int fq) const {
        const int row0 = u.pm * 256 + wr * 64 + fr, col0 = u.pn * 256 + wc * 32 + 8 * fq;
#pragma unroll
        for (int ai = 0; ai < 2; ++ai)
#pragma unroll
            for (int m = 0; m < 4; ++m) { bf16_t* rowp = O + (size_t)(row0 + ai * 128 + m * 16) * ldc + col0;
#pragma unroll
                for (int bj = 0; bj < 2; ++bj) *(u32x4*)(rowp + bj * 128) = pack8(acc[ai][bj][m][0], acc[ai][bj][m][1]); }
    }
};
struct EpiSwiGLU {
    static constexpr bool PERM = false, AFTER_DRAIN = false; bf16_t* O;
    __device__ __forceinline__ void operator()(const f32x4 (&acc)[2][2][4][2], const Unit& u, int wr, int wc, int fr, int fq) const {
        const int row0 = u.pm * 256 + wr * 64 + fr, col0 = u.pn * 128 + wc * 16 + 4 * fq;
#pragma unroll
        for (int ai = 0; ai < 2; ++ai)
#pragma unroll
            for (int m = 0; m < 4; ++m) { bf16_t* rowp = O + (size_t)(row0 + ai * 128 + m * 16) * FF + col0;
#pragma unroll
                for (int bj = 0; bj < 2; ++bj) { const f32x4 g = acc[ai][bj][m][0], up = acc[ai][bj][m][1]; f32x4 a;
#pragma unroll
                    for (int j = 0; j < 4; ++j) a[j] = g[j] * sigm_f(g[j]) * up[j];
                    *(u32x2*)(rowp + bj * 64) = pack4(a); } }
    }
};
struct EpiIn {
    static constexpr bool PERM = false, AFTER_DRAIN = false;
    bf16_t *QB, *KB, *VT, *XL, *YL, *UH; float* out; const float* rope; int l;
    __device__ __forceinline__ void operator()(const f32x4 (&acc)[2][2][4][2], const Unit& u, int wr, int wc, int fr, int fq) const {
        const int pn = u.pn; const bool lat = u.pm >= 32;
#pragma unroll
        for (int ai = 0; ai < 2; ++ai)
#pragma unroll
            for (int m = 0; m < 4; ++m) {
                const int row = u.pm * 256 + ai * 128 + wr * 64 + m * 16 + fr;
                const int t = lat ? ((row - MCTX) & 4095) : (row & 255);
#pragma unroll
                for (int bj = 0; bj < 2; ++bj) {
                    f32x4 v0 = acc[ai][bj][m][0], v1 = acc[ai][bj][m][1];
                    const int cb = 128 * bj + 32 * wc;
                    if (pn <= 2) {
                        const bool isq = pn < 2, isv = (pn == 2 && bj == 1);
                        if (lat && !isv) {
                            const int pos = (wc & 1) ? (t & 63) : (t >> 6);
                            const f32x4* rp = (const f32x4*)(rope + (pos * 16 + 4 * fq) * 2);
                            const f32x4 c01 = rp[0], c23 = rp[1];
                            const float cs[4] = {c01[0], c01[2], c23[0], c23[2]}, sn[4] = {c01[1], c01[3], c23[1], c23[3]};
#pragma unroll
                            for (int j = 0; j < 4; ++j) { const float x1 = v0[j], x2 = v1[j]; v0[j] = x1 * cs[j] - x2 * sn[j]; v1[j] = x2 * cs[j] + x1 * sn[j]; }
                        }
                        if (isq) { v0 = v0 * QSCALE; v1 = v1 * QSCALE; bf16_t* p = QB + (size_t)row * 512 + pn * 256 + cb + 4 * fq; *(u32x2*)p = pack4(v0); *(u32x2*)(p + 16) = pack4(v1); }
                        else {
                            const int kc = 32 * wc + 4 * fq;
                            if (!lat) { float* o = out + (bj ? OUT_V : OUT_K) + ((size_t)(((row >> 8) * 2 + l) * 256 + (row & 255))) * 128 + kc; *(f32x4*)o = v0; *(f32x4*)(o + 16) = v1; }
                            if (!isv) { bf16_t* p = KB + (size_t)row * 128 + kc; *(u32x2*)p = pack4(v0); *(u32x2*)(p + 16) = pack4(v1); }
                            else {
#pragma unroll
                                for (int j = 0; j < 4; ++j) { VT[(size_t)(kc + j) * M + row] = (bf16_t)f2bf(v0[j]); VT[(size_t)(kc + 16 + j) * M + row] = (bf16_t)f2bf(v1[j]); }
                            }
                        }
                    } else if (pn <= 6) {
                        bf16_t* p = (pn <= 4 ? XL : YL) + (size_t)row * 512 + ((pn - 3) & 1) * 256 + cb + 4 * fq; *(u32x2*)p = pack4(v0); *(u32x2*)(p + 16) = pack4(v1);
                    } else {
                        const int g0 = 16 * (pn - 7) + 8 * bj + 2 * wc;
                        bf16_t* p = UH + ((size_t)g0 * NCHUNK + (row >> 4)) * 512 + (row & 15) * 16 + 4 * fq;
                        *(u32x2*)p = pack4(v0); *(u32x2*)(p + (size_t)NCHUNK * 512) = pack4(v1);
                    }
                }
            }
    }
};
struct EpiS5State {
    static constexpr bool PERM = false, AFTER_DRAIN = true;
    bf16_t* UH; const float* apow; const float* init; float* out; int l;
    __device__ __forceinline__ void fused(f32x4 (&acc)[2][2][4][2], const Unit& u, int wr, int wc, int fr, int fq, PG8_LAS unsigned char* lds, int wid, int lane) const {
        const int g = u.pn, ti = u.pm - 10 * g, tid = wid * 64 + lane; const bool ctx = ti < 2;
        LAS float* T = (LAS float*)lds;
#pragma unroll
        for (int dir = 0; dir < 2; ++dir) {
#pragma unroll
            for (int ai = 0; ai < 2; ++ai)
#pragma unroll
                for (int m = 0; m < 4; ++m)
#pragma unroll
                    for (int n = 0; n < 2; ++n) *(LAS f32x4*)(T + (ai * 128 + wr * 64 + m * 16 + fr) * 132 + 32 * wc + 16 * n + 4 * fq) = acc[ai][dir][m][n];
            __syncthreads();
            if (tid < 64) {
                const int n = tid; const float* ap = apow + ((((size_t)dir * 32 + g) * 64 + n) * 17 + 16) * 2; const float ar = ap[0], aim = ap[1];
                float hr = 0.f, hi = 0.f;
                if (!ctx) { const size_t ib = ((((size_t)(ti - 2) * 2 + l) * 2 + dir) * 2) * 2048 + g * 64 + n; hr = init[ib]; hi = init[ib + 2048]; }
                for (int c0 = 0; c0 < 256; c0 += 8) {
                    float sr[8], si[8];
#pragma unroll
                    for (int k = 0; k < 8; ++k) { const int c = dir ? 255 - (c0 + k) : c0 + k; sr[k] = T[c * 132 + n]; si[k] = T[c * 132 + 64 + n]; }
#pragma unroll
                    for (int k = 0; k < 8; ++k) { const int cc = c0 + k, c = dir ? 255 - cc : cc;
                        if (ctx && (cc & 15) == 0) { hr = 0.f; hi = 0.f; }
                        T[c * 132 + n] = hr; T[c * 132 + 64 + n] = hi;
                        const float nr = ar * hr - aim * hi + sr[k], ni = ar * hi + aim * hr + si[k]; hr = nr; hi = ni;
                        if (ctx && (cc & 15) == 15) { const int seq = ti * 16 + (c >> 4); const size_t ob = OUT_SSM + ((((size_t)seq * 2 + l) * 2 + dir) * 2) * 2048 + g * 64 + n; out[ob] = hr; out[ob + 2048] = hi; }
                    }
                }
            }
            __syncthreads();
            { const int row = tid >> 1, half = tid & 1; const LAS float* s = T + row * 132 + half * 64;
              bf16_t* d = UH + ((size_t)g * NCHUNK + ti * 256 + row) * 512 + 256 + dir * 128 + half * 64;
#pragma unroll
              for (int c8 = 0; c8 < 8; ++c8) { const f32x4 a = *(const LAS f32x4*)(s + c8 * 8), b = *(const LAS f32x4*)(s + c8 * 8 + 4); *(u32x4*)(d + c8 * 8) = pack8(a, b); } }
            __syncthreads();
        }
    }
};
struct EpiS5Out {
    static constexpr bool PERM = true, AFTER_DRAIN = false; const bf16_t* UH; bf16_t* S5Y; const float* dvec;
    __device__ __forceinline__ void operator()(const f32x4 (&acc)[2][2][4][2], const Unit& u, int wr, int wc, int fr, int fq) const {
        const int g = u.pn, ti = u.pm - 10 * g, co0 = 8 * (fq & 1);
        const f32x4 d0 = *(const f32x4*)(dvec + 16 * g + co0), d1 = *(const f32x4*)(dvec + 16 * g + co0 + 4);
#pragma unroll
        for (int ai = 0; ai < 2; ++ai)
#pragma unroll
            for (int m = 0; m < 4; ++m) { const int cidx = ti * 256 + ai * 128 + wr * 64 + m * 16 + fr;
#pragma unroll
                for (int bj = 0; bj < 2; ++bj) { const int t = 8 * bj + 2 * wc + (fq >> 1);
                    const u32x4 uu = *(const u32x4*)(UH + ((size_t)g * NCHUNK + cidx) * 512 + t * 16 + co0);
                    f32x4 a = acc[ai][bj][m][0], b = acc[ai][bj][m][1];
                    a[0] = gelu_f(a[0] + d0[0] * bflo(uu.x)); a[1] = gelu_f(a[1] + d0[1] * bfhi(uu.x)); a[2] = gelu_f(a[2] + d0[2] * bflo(uu.y)); a[3] = gelu_f(a[3] + d0[3] * bfhi(uu.y));
                    b[0] = gelu_f(b[0] + d1[0] * bflo(uu.z)); b[1] = gelu_f(b[1] + d1[1] * bfhi(uu.z)); b[2] = gelu_f(b[2] + d1[2] * bflo(uu.w)); b[3] = gelu_f(b[3] + d1[3] * bfhi(uu.w));
                    *(u32x4*)(S5Y + ((size_t)cidx * 16 + t) * 512 + 16 * g + co0) = pack8(a, b); }
                asm volatile("" ::: "memory"); }
    }
};
template <int MODE> struct EpiMerge {
    static constexpr bool PERM = true, AFTER_DRAIN = false; u32x4* scr; bf16_t* O;
    __device__ __forceinline__ void operator()(const f32x4 (&acc)[2][2][4][2], const Unit& u, int wr, int wc, int fr, int fq) const {
        const int tid = pg8::opaque_tid(); u32x4* G = scr + tid; u32x4* MG = scr + 8192 + tid;
        const int row0 = u.pm * 256 + wr * 64 + fr, col0 = u.pn * 256 + wc * 32 + 8 * fq;
#pragma unroll
        for (int ai = 0; ai < 2; ++ai)
#pragma unroll
            for (int m = 0; m < 4; ++m)
#pragma unroll
                for (int bj = 0; bj < 2; ++bj) { const int i = (ai * 4 + m) * 2 + bj; f32x4 a = acc[ai][bj][m][0], b = acc[ai][bj][m][1];
                    if (MODE == 0) {
#pragma unroll
                        for (int j = 0; j < 4; ++j) { a[j] = sigm_f(a[j]); b[j] = sigm_f(b[j]); }
                        G[i * 512] = pack8(a, b);
                    } else {
                        const u32x4 gw = G[i * 512]; const f32x4 ga = {bflo(gw.x), bfhi(gw.x), bflo(gw.y), bfhi(gw.y)}, gb = {bflo(gw.z), bfhi(gw.z), bflo(gw.w), bfhi(gw.w)};
                        if (MODE == 1) MG[i * 512] = pack8(ga * a, gb * b);
                        else if (MODE == 2) G[i * 512] = pack8(ga * a, gb * b);
                        else { const u32x4 mw = MG[i * 512]; const f32x4 ma = {bflo(mw.x), bfhi(mw.x), bflo(mw.y), bfhi(mw.y)}, mb = {bflo(mw.z), bfhi(mw.z), bflo(mw.w), bfhi(mw.w)};
                            if (MODE == 3) {
#pragma unroll
                                for (int j = 0; j < 4; ++j) { a[j] = sigm_f(a[j]); b[j] = sigm_f(b[j]); }
                                MG[i * 512] = pack8(ma + ga * a, mb + gb * b);
                            } else *(u32x4*)(O + (size_t)(row0 + ai * 128 + m * 16) * D + col0 + bj * 128) = pack8(ma + ga * a, mb + gb * b);
                        }
                    }
                    if (bj == 1) asm volatile("" ::: "memory");
                }
    }
};

struct MergeOrder {
    pg8::Order base; int mode;
    __device__ bool next(int i, Unit& u) const {
        Unit t; if (!base.next(0, t)) return false;
        if (mode == 0) { if (i >= 3) return false; u.pm = t.pm; u.pn = t.pn + 4 * i; return true; }
        if (i >= 4) return false;
        if (i == 0) { u.pm = t.pm + 160; u.pn = 8 + t.pn; } else if (i == 1) { u.pm = t.pm + 640; u.pn = t.pn; } else if (i == 2) { u.pm = t.pm + 640; u.pn = 4 + t.pn; } else { u.pm = t.pm; u.pn = 12 + t.pn; }
        return true;
    }
    __device__ __forceinline__ void a_ready(const Unit&) const {}
    __device__ __forceinline__ void done(const Unit&) const {}
};
__device__ __forceinline__ void unpack8(const u32x4 w, f32x4& a, f32x4& b) { a = (f32x4){bflo(w.x), bfhi(w.x), bflo(w.y), bfhi(w.y)}; b = (f32x4){bflo(w.z), bfhi(w.z), bflo(w.w), bfhi(w.w)}; }
#define SLOT2(i) ((i) < 8 ? s2lo + (i) * 512 : s2hi + ((i) - 8) * 512)
struct EpiGates {
    static constexpr bool PERM = true, AFTER_DRAIN = false; u32x4 *s01, *s2lo, *s2hi;
    __device__ __forceinline__ void operator()(const f32x4 (&acc)[2][2][4][2], const Unit& u, int wr, int wc, int fr, int fq) const {
        const int tid = pg8::opaque_tid(), kind = u.pn >> 2;
#pragma unroll
        for (int ai = 0; ai < 2; ++ai)
#pragma unroll
            for (int m = 0; m < 4; ++m)
#pragma unroll
                for (int bj = 0; bj < 2; ++bj) { const int i = (ai * 4 + m) * 2 + bj; f32x4 a = acc[ai][bj][m][0], b = acc[ai][bj][m][1];
#pragma unroll
                    for (int j = 0; j < 4; ++j) { a[j] = sigm(a[j]); b[j] = sigm(b[j]); }
                    u32x4* d = kind == 0 ? s01 + i * 512 : (kind == 1 ? s01 + 8192 + i * 512 : SLOT2(i));
                    d[tid] = pack8(a, b); }
    }
};
struct EpiMix {
    static constexpr bool PERM = true, AFTER_DRAIN = false; u32x4 *s01, *s2lo, *s2hi; bf16_t* O;
    __device__ __forceinline__ void operator()(const f32x4 (&acc)[2][2][4][2], const Unit& u, int wr, int wc, int fr, int fq) const {
        const int tid = pg8::opaque_tid(), kind = u.pn >> 2;
        const int opm = u.pm % 160, opn = u.pn & 3, row0 = opm * 256 + wr * 64 + fr, col0 = opn * 256 + wc * 32 + 8 * fq;
#pragma unroll
        for (int ai = 0; ai < 2; ++ai)
#pragma unroll
            for (int m = 0; m < 4; ++m) {
#pragma unroll
                for (int bj = 0; bj < 2; ++bj) { const int i = (ai * 4 + m) * 2 + bj; f32x4 a = acc[ai][bj][m][0], b = acc[ai][bj][m][1];
                    u32x4* p0 = s01 + i * 512 + tid; u32x4* p1 = p0 + 8192; u32x4* p2 = SLOT2(i) + tid;
                    if (kind == 2) { f32x4 ga, gb; unpack8(*p0, ga, gb); *p0 = pack8(ga * a, gb * b); }
                    else if (kind == 0) { f32x4 ga, gb; unpack8(*p1, ga, gb); *p1 = pack8(ga * a, gb * b); }
                    else if (kind == 1) { f32x4 ga, gb, ma, mb; unpack8(*p1, ga, gb); unpack8(*p0, ma, mb);
#pragma unroll
                        for (int j = 0; j < 4; ++j) { a[j] = sigm(a[j]); b[j] = sigm(b[j]); }
                        *p0 = pack8(ma + ga * a, mb + gb * b); }
                    else { f32x4 ga, gb, ma, mb; unpack8(*p2, ga, gb); unpack8(*p0, ma, mb);
                        *(u32x4*)(O + (size_t)(row0 + ai * 128 + m * 16) * D + col0 + bj * 128) = pack8(ma + ga * a, mb + gb * b); }
                }
                asm volatile("" ::: "memory"); }
    }
};
__device__ __forceinline__ void transpose_item(const float* W, int K, int N, bf16_t* WT, int mode, LAS float* scr, int item, int lane) {
    const int nblk = N / 32, kb = item / nblk, nb = item % nblk, k0 = 64 * kb, n0 = 32 * nb;
    { const int kq = lane >> 3, n4 = (lane & 7) * 4;
      f32x4 v[8];
#pragma unroll
      for (int i = 0; i < 8; ++i) v[i] = __builtin_nontemporal_load((const f32x4*)(W + (size_t)(k0 + 8 * i + kq) * N + n0 + n4));
#pragma unroll
      for (int i = 0; i < 8; ++i) { LAS float* d = scr + (8 * i + kq) * 33 + n4; d[0] = v[i][0]; d[1] = v[i][1]; d[2] = v[i][2]; d[3] = v[i][3]; } }
    asm volatile("s_waitcnt lgkmcnt(0)" ::: "memory");
    const int c = lane & 7;
#pragma unroll
    for (int j = 0; j < 4; ++j) { const int n = (lane >> 3) + 8 * j; const LAS float* s = scr + (8 * c) * 33 + n;
        u32x4 o; o.x = cvt_pk_bf16(s[0 * 33], s[1 * 33]); o.y = cvt_pk_bf16(s[2 * 33], s[3 * 33]); o.z = cvt_pk_bf16(s[4 * 33], s[5 * 33]); o.w = cvt_pk_bf16(s[6 * 33], s[7 * 33]);
        const int gn = n0 + n, drow = mode == 0 ? gn : ((gn >> 4) * 32 + (gn & 15) + (mode == 2 ? 16 : 0));
        *(u32x4*)(WT + (size_t)drow * K + k0 + 8 * c) = o; }
    asm volatile("s_waitcnt lgkmcnt(0)" ::: "memory");
}
__device__ __forceinline__ void prep_phase(CParams& p, int l, LAS unsigned char* lds, const int G, const int bx) {
    const int tid = pg8::opaque_tid(), lane = tid & 63, wave = tid >> 6;
    unsigned char* ws = p.ws;
    {
        LAS float* scr = (LAS float*)(lds + wave * 8704);
        const int gw = bx * NWAVES + wave, NGW = G * NWAVES;
        constexpr int I_G = 16 * 88, I_D = 44 * 32, I_IN = 16 * 168, I_GLU = 8 * 64, I_O = 8 * 32, I_OUT = 16 * 32;
        constexpr int NITEMS = 4 * I_G + 2 * I_D + I_IN + I_GLU + 2 * I_O + I_OUT;
        const float* wg = p.in[12] + (size_t)l * 2 * D * FF; const float* wu = p.in[13] + (size_t)l * 2 * D * FF; const float* wd = p.in[14] + (size_t)l * 2 * FF * D;
        for (int it = gw; it < NITEMS; it += NGW) {
            int r = it;
            if (r < I_G) { transpose_item(wg, D, FF, (bf16_t*)(ws + WS_WGU0), 1, scr, r, lane); continue; } r -= I_G;
            if (r < I_G) { transpose_item(wu, D, FF, (bf16_t*)(ws + WS_WGU0), 2, scr, r, lane); continue; } r -= I_G;
            if (r < I_G) { transpose_item(wg + (size_t)D * FF, D, FF, (bf16_t*)(ws + WS_WGU1), 1, scr, r, lane); continue; } r -= I_G;
            if (r < I_G) { transpose_item(wu + (size_t)D * FF, D, FF, (bf16_t*)(ws + WS_WGU1), 2, scr, r, lane); continue; } r -= I_G;
            if (r < I_D) { transpose_item(wd, FF, D, (bf16_t*)(ws + WS_WD0), 0, scr, r, lane); continue; } r -= I_D;
            if (r < I_D) { transpose_item(wd + (size_t)FF * D, FF, D, (bf16_t*)(ws + WS_WD1), 0, scr, r, lane); continue; } r -= I_D;
            if (r < I_IN) { transpose_item(p.in[15] + (size_t)l * D * 5376, D, 5376, (bf16_t*)(ws + WS_WIN), 0, scr, r, lane); continue; } r -= I_IN;
            if (r < I_GLU) { transpose_item(p.in[31] + (size_t)l * 512 * 2048, 512, 2048, (bf16_t*)(ws + WS_WGLU), 0, scr, r, lane); continue; } r -= I_GLU;
            if (r < I_O) { transpose_item(p.in[33] + (size_t)l * 512 * D, 512, D, (bf16_t*)(ws + WS_WOL), 0, scr, r, lane); continue; } r -= I_O;
            if (r < I_O) { transpose_item(p.in[34] + (size_t)l * 512 * D, 512, D, (bf16_t*)(ws + WS_WOA), 0, scr, r, lane); continue; } r -= I_O;
            transpose_item(p.in[35] + (size_t)l * D * D, D, D, (bf16_t*)(ws + WS_WOUT), 0, scr, r, lane);
        }
    }
    const int gt = bx * NT + tid, NGT = G * NT;
    for (int i = gt; i < 4096; i += NGT) {
        const int dir = i >> 11, g = (i >> 6) & 31;
        const size_t li = ((size_t)l * 2 + dir) * 2048 + (i & 2047);
        const float lre = fminf(p.in[23][li], -1e-4f), lim = p.in[24][li], step = __expf(p.in[25][((size_t)l * 2 + dir) * 32 + g]);
        float* ap = (float*)(ws + WS_APOW) + (size_t)i * 34;
        const float mag1 = __expf(lre * step), ang1 = lim * step, abr = mag1 * __cosf(ang1), abi = mag1 * __sinf(ang1);
        { float pr = 1.f, pi = 0.f; for (int j = 0; j <= 16; ++j) { ap[2 * j] = pr; ap[2 * j + 1] = pi; const float nr = pr * abr - pi * abi, ni = pr * abi + pi * abr; pr = nr; pi = ni; } }
        const float den = lre * lre + lim * lim, nre = abr - 1.f;
        const float cre = (nre * lre + abi * lim) / den, cim = (abi * lre - nre * lim) / den;
        float* bb = (float*)(ws + WS_BBAR) + (size_t)i * 32;
        for (int ci = 0; ci < 16; ++ci) { const float br = p.in[26][li * 16 + ci], bi = p.in[27][li * 16 + ci]; bb[2 * ci] = cre * br - cim * bi; bb[2 * ci + 1] = cre * bi + cim * br; }
    }
    for (int i = gt; i < 8 * 512 * 128; i += NGT) {
        const int b = i >> 16, key = (i >> 7) & 511, c = i & 127, kvh = c >> 6, d = c & 63;
        const size_t src = (((size_t)b * 2 + l) * 512 + key) * 128 + c;
        ((bf16_t*)(ws + WS_CK))[(((size_t)b * 2 + kvh) * 512 + key) * 64 + d] = (bf16_t)f2bf(p.in[3][src]);
        ((bf16_t*)(ws + WS_CVT))[(((size_t)b * 2 + kvh) * 64 + d) * 512 + key] = (bf16_t)f2bf(p.in[4][src]);
    }
    for (int i = gt; i < 2 * 2 * 8 * 4096; i += NGT) {
        const int dir = i >> 16, gate = (i >> 15) & 1, blk = (i >> 12) & 7, o = (i >> 6) & 63, c = i & 63;
        const float* w = gate ? p.in[20] : p.in[18];
        ((bf16_t*)(ws + WS_WL))[i] = (bf16_t)f2bf(w[((((size_t)l * 2 + dir) * 8 + blk) * 64 + c) * 64 + o]);
    }
    if (l == 0) {
        for (int i = gt; i < 1024; i += NGT) { const int pos = i >> 4, k = i & 15; const float inv = __builtin_amdgcn_exp2f(-(float)k * (13.287712379549449f / 16.0f)); const float cs = __cosf((float)pos * inv), sn = __sinf((float)pos * inv);
            ((float*)(ws + WS_ROPE))[2 * i] = cs; ((float*)(ws + WS_ROPE))[2 * i + 1] = sn; }
        __syncthreads();
        LAS float* sv = (LAS float*)lds;
        LAS float* red = (LAS float*)(lds + 36864);
        for (int i = tid; i < 9 * 1024; i += NT) { const int v = i >> 10, k = i & 1023; const float x = v == 0 ? p.in[7][k] : p.in[2][(v - 1) * 1024 + k]; sv[i] = x * sigm(x); }
        __syncthreads();
        for (int it = bx; it < 288; it += G) {
            const int ll = it / 144, n0 = (it % 144) * 64, ks = tid >> 6, col = tid & 63;
            const float* w = p.in[8] + (size_t)ll * D * 9216 + n0 + col;
            float a[9];
#pragma unroll
            for (int v = 0; v < 9; ++v) a[v] = 0.f;
            for (int k = ks * 128; k < ks * 128 + 128; ++k) { const float wv = w[(size_t)k * 9216];
#pragma unroll
                for (int v = 0; v < 9; ++v) a[v] += sv[v * 1024 + k] * wv; }
#pragma unroll
            for (int v = 0; v < 9; ++v) red[(ks * 9 + v) * 64 + col] = a[v];
            __syncthreads();
            for (int i = tid; i < 576; i += NT) { const int v = i >> 6, cc = i & 63; float s = p.in[9][(size_t)ll * 9216 + n0 + cc];
#pragma unroll
                for (int k2 = 0; k2 < 8; ++k2) s += red[(k2 * 9 + v) * 64 + cc];
                ((float*)(ws + WS_MOD))[((size_t)ll * 9 + v) * 9216 + n0 + cc] = s; }
            __syncthreads();
        }
    }
}
__device__ __forceinline__ void prep2_phase(CParams& p, int l, const int G, const int bx) {
    const int tid = pg8::opaque_tid(), gt = bx * NT + tid, NGT = G * NT;
    const float* apow = (const float*)(p.ws + WS_APOW); const float* bbar = (const float*)(p.ws + WS_BBAR);
    bf16_t* TT = (bf16_t*)(p.ws + WS_TT); bf16_t* PT = (bf16_t*)(p.ws + WS_PT);
    for (int i = gt; i < 32 * 16 * 16 * 16; i += NGT) {
        const int s = i & 15, co = (i >> 4) & 15, t = (i >> 8) & 15, g = i >> 12;
        float a[16];
#pragma unroll
        for (int ci = 0; ci < 16; ++ci) a[ci] = 0.f;
#pragma unroll
        for (int dir = 0; dir < 2; ++dir) {
            if (dir == 0 ? (s > t) : (s < t)) continue;
            const int j = dir == 0 ? t - s : s - t;
            const float* cre = p.in[28] + ((((size_t)l * 2 + dir) * 32 + g) * 16 + co) * 64; const float* cim = p.in[29] + ((((size_t)l * 2 + dir) * 32 + g) * 16 + co) * 64;
            const float* ap = apow + (((size_t)dir * 32 + g) * 64) * 34 + 2 * j; const float* bb = bbar + (((size_t)dir * 32 + g) * 64) * 32;
            for (int n = 0; n < 64; ++n) {
                const float cr = cre[n], cm = cim[n], pr = ap[n * 34], pi = ap[n * 34 + 1];
                const float wr_ = cr * pr - cm * pi, wi_ = cr * pi + cm * pr;
                const f32x4* b4 = (const f32x4*)(bb + n * 32);
#pragma unroll
                for (int q = 0; q < 8; ++q) { const f32x4 v = b4[q]; a[2 * q] += wr_ * v[0] - wi_ * v[1]; a[2 * q + 1] += wr_ * v[2] - wi_ * v[3]; }
            }
        }
        bf16_t* d = TT + ((size_t)g * 256 + t * 16 + co) * 512 + s * 16;
        u32x4 o0, o1; o0.x = cvt_pk_bf16(a[0], a[1]); o0.y = cvt_pk_bf16(a[2], a[3]); o0.z = cvt_pk_bf16(a[4], a[5]); o0.w = cvt_pk_bf16(a[6], a[7]);
        o1.x = cvt_pk_bf16(a[8], a[9]); o1.y = cvt_pk_bf16(a[10], a[11]); o1.z = cvt_pk_bf16(a[12], a[13]); o1.w = cvt_pk_bf16(a[14], a[15]);
        *(u32x4*)d = o0; *(u32x4*)(d + 8) = o1;
    }
    for (int i = gt; i < 32 * 256 * 128; i += NGT) {
        const int n = i & 63, dir = (i >> 6) & 1, co = (i >> 7) & 15, t = (i >> 11) & 15, g = i >> 15;
        const size_t cb = ((((size_t)l * 2 + dir) * 32 + g) * 16 + co) * 64 + n; const float cr = p.in[28][cb], cm = p.in[29][cb];
        const float* ap = apow + (((size_t)dir * 32 + g) * 64 + n) * 34 + 2 * (dir == 0 ? t + 1 : 16 - t);
        const float wr_ = cr * ap[0] - cm * ap[1], wi_ = cr * ap[1] + cm * ap[0];
        bf16_t* d = TT + ((size_t)g * 256 + t * 16 + co) * 512 + 256 + dir * 128 + n;
        d[0] = (bf16_t)f2bf(wr_); d[64] = (bf16_t)f2bf(-wi_);
    }
    for (int i = gt; i < 32 * 2 * 64 * 256; i += NGT) {
        const int ci = i & 15, s = (i >> 4) & 15, n = (i >> 8) & 63, dir = (i >> 14) & 1, g = i >> 15;
        const float* ap = apow + (((size_t)dir * 32 + g) * 64 + n) * 34 + 2 * (dir == 0 ? 15 - s : s);
        const float* bb = bbar + (((size_t)dir * 32 + g) * 64 + n) * 32 + 2 * ci;
        const float vr = ap[0] * bb[0] - ap[1] * bb[1], vi = ap[0] * bb[1] + ap[1] * bb[0];
        bf16_t* d = PT + ((size_t)g * 256 + dir * 128 + n) * 256 + s * 16 + ci;
        d[0] = (bf16_t)f2bf(vr); d[64 * 256] = (bf16_t)f2bf(vi);
    }
}
__device__ __forceinline__ void row_phase(CParams& p, int l, int kind, const int G, const int bx, const int rlo = 0, const int rhi = M) {
    const int tid = pg8::opaque_tid(), lane = tid & 63, wave = tid >> 6;
    const float* modb = (const float*)(p.ws + WS_MOD);
    const bool upd = !(kind == 0 && l == 0), mkh = kind != 3;
    const int lu = (kind == 0 || kind == 3) ? (kind == 3 ? 1 : l - 1) : l;
    const int gidx = (kind == 0 || kind == 3) ? 8 : (kind == 1 ? 2 : 5), pidx = (kind == 0 || kind == 3) ? 2 : (kind == 1 ? 0 : 1);
    const float gs = kind == 2 ? 1.0f : 0.5f;
    const bf16_t* fsrc = (const bf16_t*)(p.ws + (kind == 2 ? WS_H : WS_F));
    const int hsub = kind == 0 ? 0 : kind;
    bf16_t* H = (bf16_t*)(p.ws + WS_H);
    const int nw = G * NWAVES; int per = (rhi - rlo + nw - 1) / nw; per += per & 1;
    const int r0 = rlo + (bx * NWAVES + wave) * per, r1 = (r0 + per) < rhi ? (r0 + per) : rhi;
    const bool from_in = (l == 0 && kind <= 1);
    const bf16_t* f2src = (const bf16_t*)(p.ws + WS_F2);
    int vcur = -1;
    f32x4 gg[4], pm[4], sh[4], xn[2][4]; u32x2 xnb[2][4], fn[2][4], fn2[2][4];
#define ROW_FETCH(r_) do { _Pragma("unroll") for (int q = 0; q < 2; ++q) { const int rr_ = (r_) + q; if (rr_ < r1) { \
        if (from_in) { const float* xs_ = rr_ < MCTX ? p.in[0] + (size_t)rr_ * D : p.in[1] + (size_t)(rr_ - MCTX) * D; \
            _Pragma("unroll") for (int j = 0; j < 4; ++j) xn[q][j] = __builtin_nontemporal_load((const f32x4*)(xs_ + 4 * lane + 256 * j)); } \
        else { const bf16_t* xs_ = (const bf16_t*)(p.out + (size_t)rr_ * D); \
            _Pragma("unroll") for (int j = 0; j < 4; ++j) xnb[q][j] = __builtin_nontemporal_load((const u32x2*)(xs_ + 4 * lane + 256 * j)); } \
        if (upd) { _Pragma("unroll") for (int j = 0; j < 4; ++j) { fn[q][j] = __builtin_nontemporal_load((const u32x2*)(fsrc + (size_t)rr_ * D + 4 * lane + 256 * j)); \
            if (rr_ >= MSPLIT) fn2[q][j] = __builtin_nontemporal_load((const u32x2*)(f2src + (size_t)(rr_ - MSPLIT) * D + 4 * lane + 256 * j)); } } } } } while (0)
    if (r0 < r1) ROW_FETCH(r0);
    for (int r = r0; r < r1; r += 2) {
        const int v = r < MCTX ? 0 : 1 + ((r - MCTX) >> 12);
        if (v != vcur) {
            vcur = v;
#pragma unroll
            for (int j = 0; j < 4; ++j) {
                if (upd) { const f32x4 ga = *(const f32x4*)(modb + ((size_t)lu * 9 + v) * 9216 + gidx * 1024 + 4 * lane + 256 * j), gq = *(const f32x4*)(p.in[11] + ((size_t)lu * 3 + pidx) * D + 4 * lane + 256 * j); gg[j] = ga * gq * gs; }
                if (mkh) { const float* mv = modb + ((size_t)l * 9 + v) * 9216 + hsub * 3 * 1024;
                    const f32x4 s_ = *(const f32x4*)(mv + 4 * lane + 256 * j), sc = *(const f32x4*)(mv + 1024 + 4 * lane + 256 * j), gq = *(const f32x4*)(p.in[10] + ((size_t)l * 3 + hsub) * D + 4 * lane + 256 * j);
                    pm[j] = gq * (sc + 1.0f); sh[j] = s_; }
            }
        }
        f32x4 x[2][4]; u32x2 fw[2][4], fw2[2][4];
#pragma unroll
        for (int q = 0; q < 2; ++q)
#pragma unroll
            for (int j = 0; j < 4; ++j) { x[q][j] = from_in ? xn[q][j] : (f32x4){bflo(xnb[q][j].x), bfhi(xnb[q][j].x), bflo(xnb[q][j].y), bfhi(xnb[q][j].y)}; fw[q][j] = fn[q][j]; fw2[q][j] = fn2[q][j]; }
        if (r + 2 < r1) ROW_FETCH(r + 2);
        const bool two = r + 1 < r1, hi2 = r >= MSPLIT;
        if (upd) {
            f32x4 f[2][4]; float ss[2] = {0.f, 0.f};
#pragma unroll
            for (int q = 0; q < 2; ++q)
#pragma unroll
                for (int j = 0; j < 4; ++j) { f[q][j] = (f32x4){bflo(fw[q][j].x), bfhi(fw[q][j].x), bflo(fw[q][j].y), bfhi(fw[q][j].y)}; if (hi2) f[q][j] = f[q][j] + (f32x4){bflo(fw2[q][j].x), bfhi(fw2[q][j].x), bflo(fw2[q][j].y), bfhi(fw2[q][j].y)};
                    ss[q] += f[q][j][0] * f[q][j][0] + f[q][j][1] * f[q][j][1] + f[q][j][2] * f[q][j][2] + f[q][j][3] * f[q][j][3]; }
#pragma unroll
            for (int o = 1; o < 64; o <<= 1) { ss[0] += shx(ss[0], o, lane); ss[1] += shx(ss[1], o, lane); }
#pragma unroll
            for (int q = 0; q < 2; ++q) { const float rstd = rsqrtf(ss[q] * (1.f / D) + RMS_EPS);
#pragma unroll
                for (int j = 0; j < 4; ++j) x[q][j] = x[q][j] + gg[j] * (f[q][j] * rstd); }
        }
#pragma unroll
        for (int q = 0; q < 2; ++q) { if (q == 1 && !two) break;
            if (kind == 3) {
#pragma unroll
                for (int j = 0; j < 4; ++j) __builtin_nontemporal_store(x[q][j], (f32x4*)(p.out + (size_t)(r + q) * D + 4 * lane + 256 * j));
            } else if (upd) {
#pragma unroll
                for (int j = 0; j < 4; ++j) __builtin_nontemporal_store(pack4(x[q][j]), (u32x2*)((bf16_t*)(p.out + (size_t)(r + q) * D) + 4 * lane + 256 * j));
            } }
        if (mkh) {
            float ss[2] = {0.f, 0.f};
#pragma unroll
            for (int q = 0; q < 2; ++q)
#pragma unroll
                for (int j = 0; j < 4; ++j) ss[q] += x[q][j][0] * x[q][j][0] + x[q][j][1] * x[q][j][1] + x[q][j][2] * x[q][j][2] + x[q][j][3] * x[q][j][3];
#pragma unroll
            for (int o = 1; o < 64; o <<= 1) { ss[0] += shx(ss[0], o, lane); ss[1] += shx(ss[1], o, lane); }
#pragma unroll
            for (int q = 0; q < 2; ++q) { if (q == 1 && !two) break; const float rstd = rsqrtf(ss[q] * (1.f / D) + RMS_EPS);
#pragma unroll
                for (int j = 0; j < 4; ++j) { const f32x4 h = (x[q][j] * rstd) * pm[j] + sh[j]; *(u32x2*)(H + (size_t)(r + q) * D + 4 * lane + 256 * j) = pack4(h); } }
        }
    }
#undef ROW_FETCH
}
template <int PASS> __device__ __forceinline__ void lru_pass(CParams& p, int l, LAS unsigned char* lds, const int G, const int bx, bf16_t* ydst) {
    const int tid = pg8::opaque_tid(), lane = tid & 63, wave = tid >> 6, fr = lane & 15, fq = lane >> 4;
    const int blk = bx & 7, ttstep = G >> 3;
    const bf16_t* XL = (const bf16_t*)(p.ws + WS_XL);
    LAS float* xc = (LAS float*)lds;
    LAS bf16_t* xb = (LAS bf16_t*)(lds + 16640);
    LAS float* AB = (LAS float*)(lds + 16640 + 9216);
    const int ct = tid >> 3, c0 = (tid & 7) * 8, cch = blk * 64 + c0;
    float wcv[4][8], bcv[8];
    {
        const float* bc = p.in[17] + (size_t)l * 512 + cch;
#pragma unroll
        for (int k = 0; k < 8; ++k) bcv[k] = bc[k];
#pragma unroll
        for (int j = 0; j < 4; ++j) { const float* wc = p.in[16] + ((size_t)l * 4 + j) * 512 + cch;
#pragma unroll
            for (int k = 0; k < 8; ++k) wcv[j][k] = wc[k]; }
    }
    const int dir = wave >> 2, tq = wave & 3;
    bf16x8 wfa[4][2], wfx[4][2]; float pba[4], pbx[4], psp[4];
    {
        const bf16_t* WL = (const bf16_t*)(p.ws + WS_WL) + ((size_t)(dir * 2) * 8 + blk) * 4096;
#pragma unroll
        for (int nb = 0; nb < 4; ++nb) {
#pragma unroll
            for (int kk = 0; kk < 2; ++kk) { wfa[nb][kk] = *(const bf16x8*)(WL + (16 * nb + fr) * 64 + 32 * kk + 8 * fq); wfx[nb][kk] = *(const bf16x8*)(WL + 8 * 4096 + (16 * nb + fr) * 64 + 32 * kk + 8 * fq); }
            const size_t pb = ((size_t)l * 2 + dir) * 512 + blk * 64 + 16 * nb + fr;
            pba[nb] = p.in[19][pb]; pbx[nb] = p.in[21][pb]; psp[nb] = -8.0f * 1.4426950408889634f * __logf(1.0f + __expf(-p.in[22][pb]));
        }
    }
    u32x4 xr[4]; u32x4 ylr; float cinr = 0.f;
#define LRU_FETCH(tt_) do { const int row0_ = (tt_) * 64; const int seqlen_ = row0_ < MCTX ? 256 : 4096, tp0_ = row0_ < MCTX ? (row0_ & 255) : ((row0_ - MCTX) & 4095); \
        _Pragma("unroll") for (int j = 0; j < 4; ++j) { const int tp = tp0_ + ct + j - 2; xr[j] = (u32x4){0u, 0u, 0u, 0u}; if (tp >= 0 && tp < seqlen_) xr[j] = *(const u32x4*)(XL + (size_t)(row0_ + ct + j - 2) * 512 + cch); } \
        if (PASS == 3) { ylr = *(const u32x4*)((const bf16_t*)(p.ws + WS_YL) + (size_t)(row0_ + ct) * 512 + cch); if (tid < 128) cinr = ((const float*)(p.ws + WS_CIN))[((size_t)(tid >> 6) * 640 + (tt_)) * 512 + blk * 64 + (tid & 63)]; } } while (0)
    const bool rebal = (G == 256);
    const int nown = rebal ? (bx < 64 ? 17 : 20) : (640 - (bx >> 3) + ttstep - 1) / ttstep, ntl = nown + ((rebal && bx >= 64) ? 1 : 0);
    const int ttx = ((bx & 63) >> 3) + 32 * (16 + (bx >> 6));
#define LRU_TT(q_) ((q_) < nown ? (bx >> 3) + (q_) * ttstep : ttx)
    if (ntl > 0) LRU_FETCH(LRU_TT(0));
    for (int q = 0; q < ntl; ++q) {
        const int tt = LRU_TT(q);
        {
            float a[8];
#pragma unroll
            for (int k = 0; k < 8; ++k) a[k] = bcv[k];
#pragma unroll
            for (int j = 0; j < 4; ++j) { const u32x4 w = xr[j];
                a[0] += bflo(w.x) * wcv[j][0]; a[1] += bfhi(w.x) * wcv[j][1]; a[2] += bflo(w.y) * wcv[j][2]; a[3] += bfhi(w.y) * wcv[j][3]; a[4] += bflo(w.z) * wcv[j][4]; a[5] += bfhi(w.z) * wcv[j][5]; a[6] += bflo(w.w) * wcv[j][6]; a[7] += bfhi(w.w) * wcv[j][7]; }
#pragma unroll
            for (int k = 0; k < 8; ++k) xc[ct * 65 + c0 + k] = a[k];
            u32x4 o; o.x = cvt_pk_bf16(a[0], a[1]); o.y = cvt_pk_bf16(a[2], a[3]); o.z = cvt_pk_bf16(a[4], a[5]); o.w = cvt_pk_bf16(a[6], a[7]);
            *(LAS u32x4*)(xb + ct * 72 + c0) = o;
        }
        u32x4 ylc; float cinc = 0.f; if (PASS == 3) { ylc = ylr; cinc = cinr; }
        if (q + 1 < ntl) LRU_FETCH(LRU_TT(q + 1));
        __syncthreads();
        {
            bf16x8 af[2];
#pragma unroll
            for (int kk = 0; kk < 2; ++kk) af[kk] = *(const LAS bf16x8*)(xb + (16 * tq + fr) * 72 + 32 * kk + 8 * fq);
#pragma unroll
            for (int nb = 0; nb < 4; ++nb) {
                f32x4 za = {0.f, 0.f, 0.f, 0.f}, zx = {0.f, 0.f, 0.f, 0.f};
#pragma unroll
                for (int kk = 0; kk < 2; ++kk) { za = __builtin_amdgcn_mfma_f32_16x16x32_bf16(af[kk], wfa[nb][kk], za, 0, 0, 0); zx = __builtin_amdgcn_mfma_f32_16x16x32_bf16(af[kk], wfx[nb][kk], zx, 0, 0, 0); }
                const int c = 16 * nb + fr;
#pragma unroll
                for (int j = 0; j < 4; ++j) { const int t = 16 * tq + 4 * fq + j;
                    const float r = sigm_f(za[j] + pba[nb]), ig = sigm_f(zx[j] + pbx[nb]), a = __builtin_amdgcn_exp2f(r * psp[nb]),
                        em = __builtin_fmaf(-a, a, 1.0f), b = __builtin_amdgcn_sqrtf(em) * (ig * xc[t * 65 + c]);
                    AB[(dir * 64 + t) * 64 + c] = a; AB[8192 + (dir * 64 + t) * 64 + c] = b; }
            }
        }
        __syncthreads();
        if (tid < 128) {
            const int sd = tid >> 6, c = tid & 63, ch = blk * 64 + c;
            LAS float* A = AB + sd * 4096 + c; LAS float* B = A + 8192;
            if (PASS == 1) {
                float P = 1.f, h = 0.f;
#pragma unroll 1
                for (int k0 = 0; k0 < 64; k0 += 8) { float a[8], b[8];
#pragma unroll
                    for (int k = 0; k < 8; ++k) { const int t = sd ? 63 - (k0 + k) : k0 + k; a[k] = A[t * 64]; b[k] = B[t * 64]; }
#pragma unroll
                    for (int k = 0; k < 8; ++k) { h = a[k] * h + b[k]; P *= a[k]; } }
                float* ag = (float*)(p.ws + WS_AGG) + (((size_t)sd * 640 + tt) * 512 + ch) * 2; ag[0] = P; ag[1] = h;
            } else {
                float h = cinc;
#pragma unroll 1
                for (int k0 = 0; k0 < 64; k0 += 8) { float a[8], b[8];
#pragma unroll
                    for (int k = 0; k < 8; ++k) { const int t = sd ? 63 - (k0 + k) : k0 + k; a[k] = A[t * 64]; b[k] = B[t * 64]; }
#pragma unroll
                    for (int k = 0; k < 8; ++k) { const int t = sd ? 63 - (k0 + k) : k0 + k; h = a[k] * h + b[k]; B[t * 64] = h; } }
            }
        }
        if (PASS == 3) {
            __syncthreads();
            bf16_t* yp = ydst + (size_t)(tt * 64 + ct) * 512 + cch;
            const u32x4 w = ylc; const float yl[8] = {bflo(w.x), bfhi(w.x), bflo(w.y), bfhi(w.y), bflo(w.z), bfhi(w.z), bflo(w.w), bfhi(w.w)};
            float o[8];
#pragma unroll
            for (int k = 0; k < 8; ++k) o[k] = (AB[8192 + ct * 64 + c0 + k] + AB[8192 + 4096 + ct * 64 + c0 + k]) * gelu_f(yl[k]);
            u32x4 ov; ov.x = cvt_pk_bf16(o[0], o[1]); ov.y = cvt_pk_bf16(o[2], o[3]); ov.z = cvt_pk_bf16(o[4], o[5]); ov.w = cvt_pk_bf16(o[6], o[7]);
            *(u32x4*)yp = ov;
        }
    }
#undef LRU_FETCH
#undef LRU_TT
    __syncthreads();
}
__device__ __forceinline__ void lru_carry(CParams& p, int l, const int G, const int bx) {
    const float* AGG = (const float*)(p.ws + WS_AGG); float* CIN = (float*)(p.ws + WS_CIN);
    for (int i = bx * NT + pg8::opaque_tid(); i < 40 * 2 * 512; i += G * NT) {
        const int ch = i & 511, dir = (i >> 9) & 1, seq = i >> 10;
        const bool ctx = seq < 32; const int nt = ctx ? 4 : 64, t0 = ctx ? seq * 4 : 128 + (seq - 32) * 64;
        float h = ctx ? 0.f : p.in[5][(((size_t)(seq - 32) * 2 + l) * 2 + dir) * 512 + ch];
        for (int k0 = 0; k0 < nt; k0 += 16) { f32x2 ab[16];
#pragma unroll
            for (int k = 0; k < 16; ++k) if (k0 + k < nt) { const int tt = t0 + (dir ? nt - 1 - (k0 + k) : k0 + k); ab[k] = *(const f32x2*)(AGG + 2 * (((size_t)dir * 640 + tt) * 512 + ch)); }
#pragma unroll
            for (int k = 0; k < 16; ++k) if (k0 + k < nt) { const int tt = t0 + (dir ? nt - 1 - (k0 + k) : k0 + k); CIN[((size_t)dir * 640 + tt) * 512 + ch] = h; h = ab[k][0] * h + ab[k][1]; } }
        if (ctx) p.out[OUT_LRU + (((size_t)seq * 2 + l) * 2 + dir) * 512 + ch] = h;
    }
}
__device__ __forceinline__ void attn_tile(const LAS bf16_t* Kb, const LAS bf16_t* Vb, const bf16x8 (&qf)[2][2], f32x4 (&o)[4][2], float (&mrun)[2], float (&lrun)[2], const bool masked, const int key0, const int qw, const int fr, const int fq, const int lane) {
    f32x4 s[2][4];
#pragma unroll
    for (int m = 0; m < 2; ++m)
#pragma unroll
        for (int n = 0; n < 4; ++n) s[m][n] = (f32x4){0.f, 0.f, 0.f, 0.f};
#pragma unroll
    for (int n = 0; n < 4; ++n)
#pragma unroll
        for (int kk = 0; kk < 2; ++kk) { const bf16x8 kf = *(const LAS bf16x8*)(Kb + (16 * n + fr) * 72 + 32 * kk + 8 * fq);
#pragma unroll
            for (int m = 0; m < 2; ++m) s[m][n] = __builtin_amdgcn_mfma_f32_16x16x32_bf16(kf, qf[m][kk], s[m][n], 0, 0, 0); }
    if (masked) {
#pragma unroll
        for (int m = 0; m < 2; ++m) { const int q = qw + 16 * m + fr;
#pragma unroll
            for (int n = 0; n < 4; ++n)
#pragma unroll
                for (int j = 0; j < 4; ++j) { const int dk = key0 + 16 * n + 4 * fq + j - q; if (dk > 128 || dk < -128) s[m][n][j] = -1e30f; } }
    }
    bf16x8 pf[2][2];
#pragma unroll
    for (int m = 0; m < 2; ++m) {
        float mx = s[m][0][0];
#pragma unroll
        for (int n = 0; n < 4; ++n)
#pragma unroll
            for (int j = 0; j < 4; ++j) mx = fmaxf(mx, s[m][n][j]);
        mx = fmaxf(mx, shx(mx, 16, lane)); mx = fmaxf(mx, shx(mx, 32, lane));
        const float mn = fmaxf(mrun[m], mx), al = __builtin_amdgcn_exp2f(mrun[m] - mn); mrun[m] = mn;
        float ps = 0.f;
#pragma unroll
        for (int n = 0; n < 4; ++n)
#pragma unroll
            for (int j = 0; j < 4; ++j) { const float e = __builtin_amdgcn_exp2f(s[m][n][j] - mn); s[m][n][j] = e; ps += e; }
        lrun[m] = lrun[m] * al + ps;
        if (__any(al < 1.0f)) {
#pragma unroll
            for (int db = 0; db < 4; ++db) o[db][m] = o[db][m] * al;
        }
#pragma unroll
        for (int kk = 0; kk < 2; ++kk) { const u32x4 w = pack8(s[m][2 * kk], s[m][2 * kk + 1]); pf[m][kk] = __builtin_bit_cast(bf16x8, w); }
    }
#pragma unroll
    for (int db = 0; db < 4; ++db)
#pragma unroll
        for (int kk = 0; kk < 2; ++kk) {
            const u32x2 v0 = *(const LAS u32x2*)(Vb + (16 * db + fr) * 72 + 32 * kk + 4 * fq), v1 = *(const LAS u32x2*)(Vb + (16 * db + fr) * 72 + 32 * kk + 16 + 4 * fq);
            const u32x4 vw = {v0.x, v0.y, v1.x, v1.y}; const bf16x8 vf = __builtin_bit_cast(bf16x8, vw);
#pragma unroll
            for (int m = 0; m < 2; ++m) o[db][m] = __builtin_amdgcn_mfma_f32_16x16x32_bf16(vf, pf[m][kk], o[db][m], 0, 0, 0);
        }
}
__device__ __forceinline__ void attn_unit(CParams& p, int l, int unit, LAS unsigned char* lds, bf16_t* odst) {
    const int tid = pg8::opaque_tid(), lane = tid & 63, wave = tid >> 6, fr = lane & 15, fq = lane >> 4;
    int seq, hp, qb, T, rowbase; bool lat;
    if (unit < 1024) { lat = true; seq = unit >> 7; hp = (unit >> 5) & 3; qb = unit & 31; T = 4096; rowbase = MCTX + seq * 4096; }
    else { const int u2 = unit - 1024; lat = false; seq = u2 >> 3; hp = (u2 >> 1) & 3; qb = u2 & 1; T = 256; rowbase = seq * 256; }
    const int kvh = hp >> 1, head = hp * 2 + (wave >> 2), q0 = qb * 128, qw = q0 + 32 * (wave & 3);
    int kstart, nloc;
    if (lat) { kstart = q0 - 128 < 0 ? 0 : q0 - 128; const int kend = q0 + 256 > T ? T : q0 + 256; nloc = (kend - kstart) >> 6; } else { kstart = 0; nloc = 4; }
    const int ntile = lat ? nloc + 8 : nloc;
    bf16_t* QB = (bf16_t*)(p.ws + WS_QB);
    const bf16_t* KB = (const bf16_t*)(p.ws + WS_KB); const bf16_t* VT = (const bf16_t*)(p.ws + WS_VT);
    const bf16_t* CK = (const bf16_t*)(p.ws + WS_CK); const bf16_t* CVT = (const bf16_t*)(p.ws + WS_CVT);
    LAS bf16_t* Kl = (LAS bf16_t*)lds;
    LAS bf16_t* Vl = (LAS bf16_t*)(lds + 18432);
    const int lr = tid >> 3, lc = (tid & 7) * 8;
#define ATT_LOAD(tix) do { if ((tix) < nloc) { const int key0 = kstart + 64 * (tix); \
            kreg = *(const u32x4*)(KB + (size_t)(rowbase + key0 + lr) * 128 + kvh * 64 + lc); vreg = *(const u32x4*)(VT + (size_t)(kvh * 64 + lr) * M + rowbase + key0 + lc); } \
        else { const int c_ = (tix) - nloc; kreg = *(const u32x4*)(CK + (((size_t)seq * 2 + kvh) * 512 + 64 * c_ + lr) * 64 + lc); vreg = *(const u32x4*)(CVT + (((size_t)seq * 2 + kvh) * 64 + lr) * 512 + 64 * c_ + lc); } } while (0)
#define ATT_STORE(buf) do { *(LAS u32x4*)(Kl + (buf) * 4608 + lr * 72 + lc) = kreg; *(LAS u32x4*)(Vl + (buf) * 4608 + lr * 72 + lc) = vreg; } while (0)
    u32x4 kreg, vreg, kreg2, vreg2;
#define ATT_LOAD2(tix) do { if ((tix) < nloc) { const int key0 = kstart + 64 * (tix); \
            kreg2 = *(const u32x4*)(KB + (size_t)(rowbase + key0 + lr) * 128 + kvh * 64 + lc); vreg2 = *(const u32x4*)(VT + (size_t)(kvh * 64 + lr) * M + rowbase + key0 + lc); } \
        else { const int c_ = (tix) - nloc; kreg2 = *(const u32x4*)(CK + (((size_t)seq * 2 + kvh) * 512 + 64 * c_ + lr) * 64 + lc); vreg2 = *(const u32x4*)(CVT + (((size_t)seq * 2 + kvh) * 64 + lr) * 512 + 64 * c_ + lc); } } while (0)
#define ATT_STORE2(buf) do { *(LAS u32x4*)(Kl + (buf) * 4608 + lr * 72 + lc) = kreg2; *(LAS u32x4*)(Vl + (buf) * 4608 + lr * 72 + lc) = vreg2; } while (0)
    ATT_LOAD(0);
    if (1 < ntile) ATT_LOAD2(1);
    bf16x8 qf[2][2];
#pragma unroll
    for (int m = 0; m < 2; ++m)
#pragma unroll
        for (int kk = 0; kk < 2; ++kk) qf[m][kk] = *(const bf16x8*)(QB + (size_t)(rowbase + qw + 16 * m + fr) * 512 + head * 64 + 32 * kk + 8 * fq);
    const float sink2 = p.in[32][l * 8 + head] * LOG2E;
    float mrun[2] = {sink2, sink2}, lrun[2] = {fq == 0 ? 1.f : 0.f, fq == 0 ? 1.f : 0.f};
    f32x4 o[4][2];
#pragma unroll
    for (int db = 0; db < 4; ++db)
#pragma unroll
        for (int m = 0; m < 2; ++m) o[db][m] = (f32x4){0.f, 0.f, 0.f, 0.f};
    ATT_STORE(0);
    __syncthreads();
    for (int tix = 0; tix < ntile; tix += 2) {
        if (tix + 2 < ntile) ATT_LOAD(tix + 2);
        { const bool loc_ = lat && tix < nloc; const int k0_ = kstart + 64 * tix;
          if (!(loc_ && (k0_ > qw + 159 || k0_ + 63 < qw - 128))) attn_tile(Kl, Vl, qf, o, mrun, lrun, loc_, k0_, qw, fr, fq, lane); }
        if (tix + 1 < ntile) ATT_STORE2(1);
        __syncthreads();
        if (tix + 1 < ntile) {
            if (tix + 3 < ntile) ATT_LOAD2(tix + 3);
            { const bool loc_ = lat && tix + 1 < nloc; const int k0_ = kstart + 64 * (tix + 1);
              if (!(loc_ && (k0_ > qw + 159 || k0_ + 63 < qw - 128))) attn_tile(Kl + 4608, Vl + 4608, qf, o, mrun, lrun, loc_, k0_, qw, fr, fq, lane); }
            if (tix + 2 < ntile) ATT_STORE(0);
            __syncthreads();
        }
    }
#pragma unroll
    for (int m = 0; m < 2; ++m) {
        float lt = lrun[m]; lt += shx(lt, 16, lane); lt += shx(lt, 32, lane);
        const float inv = 1.0f / lt;
        bf16_t* op = odst + (size_t)(rowbase + qw + 16 * m + fr) * 512 + head * 64 + 4 * fq;
#pragma unroll
        for (int db = 0; db < 4; ++db) *(u32x2*)(op + 16 * db) = pack4(o[db][m] * inv);
    }
#undef ATT_LOAD
#undef ATT_STORE
#undef ATT_LOAD2
#undef ATT_STORE2
}
struct OneUnit { int pm, pn;
    __device__ bool next(int i, Unit& u) const { if (i) return false; u.pm = pm; u.pn = pn; return true; }
    __device__ __forceinline__ void a_ready(const Unit&) const {}
    __device__ __forceinline__ void done(const Unit&) const {} };
struct PanelOrder { int pm;
    __device__ bool next(int i, Unit& u) const { if (i >= 4) return false; u.pm = pm; u.pn = i; return true; }
    __device__ __forceinline__ void a_ready(const Unit&) const {}
    __device__ __forceinline__ void done(const Unit&) const {} };
__device__ __forceinline__ void gemm_n1024_full(LAS unsigned char* lds, const bf16_t* A, const bf16_t* Bt, const int K, bf16_t* O, const int Gs, const int cs) {
    pg8::Gemm g{A, Bt, MSPLIT, D, K, K, K}; pg8::Order S; S.init(MSPLIT, D, Gs, cs); EpiPlain E{O, D}; pg8::gemm_phase<EpiPlain, pg8::Order, true, true>(lds, g, S, E);
}
__device__ __forceinline__ void gemm_n1024_halves(LAS unsigned char* lds, const bf16_t* A, const bf16_t* Bt, const int K, bf16_t* O, bf16_t* O2, const int G, const int bx) {
    for (int u = bx; u < 256; u += G) { const int t = u >> 1, kh = u & 1, Kh = K >> 1;
        pg8::Gemm g{A + kh * Kh, Bt + kh * Kh, M, D, Kh, K, K}; OneUnit S{128 + (t >> 2), t & 3}; EpiPlain E{kh ? O2 - (size_t)MSPLIT * D : O, D};
        pg8::gemm_phase<EpiPlain, OneUnit, true, true>(lds, g, S, E); }
}
__device__ __forceinline__ void gemm_n1024_splitk(LAS unsigned char* lds, const bf16_t* A, const bf16_t* Bt, const int K, bf16_t* O, bf16_t* O2, const int G, const int bx) {
    gemm_n1024_full(lds, A, Bt, K, O, G, bx); gemm_n1024_halves(lds, A, Bt, K, O, O2, G, bx);
}
template <class Sched> __device__ __forceinline__ void merge_chain(LAS unsigned char* lds, unsigned char* ws, const bf16_t* H, pg8::u32x4* scr, const Sched& S) {
    const bf16_t* WIN = (const bf16_t*)(ws + WS_WIN); bf16_t* MG = (bf16_t*)(ws + WS_MERGED);
    { pg8::Gemm g{H, WIN + (size_t)2304 * D, M, D, D, D, D}; EpiMerge<0> E{scr, MG}; pg8::gemm_phase<EpiMerge<0>, Sched, true, true>(lds, g, S, E); }
    { pg8::Gemm g{(const bf16_t*)(ws + WS_YL), (const bf16_t*)(ws + WS_WOL), M, D, 512, 512, 512}; EpiMerge<1> E{scr, MG}; pg8::gemm_phase<EpiMerge<1>, Sched, true, true>(lds, g, S, E); }
    { pg8::Gemm g{H, WIN + (size_t)3328 * D, M, D, D, D, D}; EpiMerge<0> E{scr, MG}; pg8::gemm_phase<EpiMerge<0>, Sched, true, true>(lds, g, S, E); }
    { pg8::Gemm g{(const bf16_t*)(ws + WS_S5Y), (const bf16_t*)(ws + WS_WGLU), M, D, 512, 512, 512}; EpiMerge<2> E{scr, MG}; pg8::gemm_phase<EpiMerge<2>, Sched, true, true>(lds, g, S, E); }
    { pg8::Gemm g{(const bf16_t*)(ws + WS_S5Y), (const bf16_t*)(ws + WS_WGLU) + (size_t)1024 * 512, M, D, 512, 512, 512}; EpiMerge<3> E{scr, MG}; pg8::gemm_phase<EpiMerge<3>, Sched, true, true>(lds, g, S, E); }
    { pg8::Gemm g{H, WIN + (size_t)4352 * D, M, D, D, D, D}; EpiMerge<0> E{scr, MG}; pg8::gemm_phase<EpiMerge<0>, Sched, true, true>(lds, g, S, E); }
    { pg8::Gemm g{(const bf16_t*)(ws + WS_QB), (const bf16_t*)(ws + WS_WOA), M, D, 512, 512, 512}; EpiMerge<4> E{scr, MG}; pg8::gemm_phase<EpiMerge<4>, Sched, true, true>(lds, g, S, E); }
}
constexpr int NPHASE = 29;
#ifndef ONLY_K
#define ONLY_K -1
#endif
#define EN(n) (ONLY_K < 0 || ONLY_K == (n) || ONLY_K / 10 == (n))
#define SUB(j) (ONLY_K < 20 || ONLY_K % 10 == (j))
#ifndef MK_SPLIT
#define MK_SPLIT 0
#endif
constexpr int REPS[14] = {1, 1, 1, 1, 1, 1, 1, 1, 1, 1, 1, 1, 1, 1};
constexpr int EXTRA_SYNCS = 0;
constexpr bool PROBE_ATT = false, PROBE_MIXB = false;
#define PH_ON(q) (ph_lo <= (q) && (q) < ph_hi)
template <int l> __device__ __forceinline__ void run_layer(CParams* kp, const int ph_lo, const int ph_hi, LAS unsigned char* lds, cg::grid_group& grid, const XcdBarrier& xbar) {
    if (PH_ON(14 * l + 0)) {
      _Pragma("unroll") for (int rep = 0; rep < REPS[0]; ++rep) { if (rep) xcd_barrier(xbar);
        { CParams* kq = kp; asm volatile("" : "+s"(kq)); CParams& p = *kq; unsigned char* ws = p.ws; (void)ws;
          int G = gridDim.x, bx = blockIdx.x; asm volatile("" : "+s"(G), "+s"(bx));
          bf16_t* H = (bf16_t*)(ws + WS_H); bf16_t* F = (bf16_t*)(ws + WS_F); (void)H; (void)F;
          prep_phase(p, l, lds, G, bx);
        } }
        if (14 * l + 0 + 1 < ph_hi) { if (l == 0 && ph_hi < 0) grid.sync();
                                      xcd_barrier(xbar); }
    }
    if (PH_ON(14 * l + 1)) {
      _Pragma("unroll") for (int rep = 0; rep < REPS[1]; ++rep) { if (rep) xcd_barrier(xbar);
        { CParams* kq = kp; asm volatile("" : "+s"(kq)); CParams& p = *kq; unsigned char* ws = p.ws; (void)ws;
          int G = gridDim.x, bx = blockIdx.x; asm volatile("" : "+s"(G), "+s"(bx));
          bf16_t* H = (bf16_t*)(ws + WS_H); bf16_t* F = (bf16_t*)(ws + WS_F); (void)H; (void)F;
          prep2_phase(p, l, G, bx); row_phase(p, l, 0, G, bx);
        } }
        if (14 * l + 1 + 1 < ph_hi) xcd_barrier(xbar);
    }
    if (PH_ON(14 * l + 2)) {
      _Pragma("unroll") for (int rep = 0; rep < REPS[2]; ++rep) { if (rep) xcd_barrier(xbar);
        { CParams* kq = kp; asm volatile("" : "+s"(kq)); CParams& p = *kq; unsigned char* ws = p.ws; (void)ws;
          int G = gridDim.x, bx = blockIdx.x; asm volatile("" : "+s"(G), "+s"(bx));
          bf16_t* H = (bf16_t*)(ws + WS_H); bf16_t* F = (bf16_t*)(ws + WS_F); (void)H; (void)F;
          {
            pg8::Gemm g{H, (const bf16_t*)(ws + WS_WGU0), M, 2 * FF, D, D, D}; pg8::Order S; S.init(M, 2 * FF, G, bx);
            EpiSwiGLU E{(bf16_t*)(ws + WS_ACT)};
            pg8::gemm_phase<EpiSwiGLU, pg8::Order, true, true>(lds, g, S, E);
        }
        } }
        if (14 * l + 2 + 1 < ph_hi) xcd_barrier(xbar);
    }
    if (PH_ON(14 * l + 3)) {
      _Pragma("unroll") for (int rep = 0; rep < REPS[3]; ++rep) { if (rep) xcd_barrier(xbar);
        { CParams* kq = kp; asm volatile("" : "+s"(kq)); CParams& p = *kq; unsigned char* ws = p.ws; (void)ws;
          int G = gridDim.x, bx = blockIdx.x; asm volatile("" : "+s"(G), "+s"(bx));
          bf16_t* H = (bf16_t*)(ws + WS_H); bf16_t* F = (bf16_t*)(ws + WS_F); (void)H; (void)F;
          {
            gemm_n1024_splitk(lds, (const bf16_t*)(ws + WS_ACT), (const bf16_t*)(ws + WS_WD0), FF, F, (bf16_t*)(ws + WS_F2), G, bx);
        }
        } }
        if (14 * l + 3 + 1 < ph_hi) xcd_barrier(xbar);
    }
    if (PH_ON(14 * l + 4)) {
      _Pragma("unroll") for (int rep = 0; rep < REPS[4]; ++rep) { if (rep) xcd_barrier(xbar);
        { CParams* kq = kp; asm volatile("" : "+s"(kq)); CParams& p = *kq; unsigned char* ws = p.ws; (void)ws;
          int G = gridDim.x, bx = blockIdx.x; asm volatile("" : "+s"(G), "+s"(bx));
          bf16_t* H = (bf16_t*)(ws + WS_H); bf16_t* F = (bf16_t*)(ws + WS_F); (void)H; (void)F;
          row_phase(p, l, 1, G, bx);
        } }
        if (14 * l + 4 + 1 < ph_hi) xcd_barrier(xbar);
    }
    if (PH_ON(14 * l + 5)) {
      _Pragma("unroll") for (int rep = 0; rep < REPS[5]; ++rep) { if (rep) xcd_barrier(xbar);
        { CParams* kq = kp; asm volatile("" : "+s"(kq)); CParams& p = *kq; unsigned char* ws = p.ws; (void)ws;
          int G = gridDim.x, bx = blockIdx.x; asm volatile("" : "+s"(G), "+s"(bx));
          bf16_t* H = (bf16_t*)(ws + WS_H); bf16_t* F = (bf16_t*)(ws + WS_F); (void)H; (void)F;
          {
            pg8::Gemm g{H, (const bf16_t*)(ws + WS_WIN), M, NIN, D, D, D}; pg8::Order S; S.init(M, NIN, G, bx);
            EpiIn E{(bf16_t*)(ws + WS_QB), (bf16_t*)(ws + WS_KB), (bf16_t*)(ws + WS_VT), (bf16_t*)(ws + WS_XL), (bf16_t*)(ws + WS_YL), (bf16_t*)(ws + WS_UH), p.out, (const float*)(ws + WS_ROPE), l};
            pg8::gemm_phase<EpiIn, pg8::Order, true, true>(lds, g, S, E);
        }
        } }
        if (14 * l + 5 + 1 < ph_hi) xcd_barrier(xbar);
    }
    if (PH_ON(14 * l + 6)) {
      _Pragma("unroll") for (int rep = 0; rep < REPS[6]; ++rep) { if (rep) xcd_barrier(xbar);
        { CParams* kq = kp; asm volatile("" : "+s"(kq)); CParams& p = *kq; unsigned char* ws = p.ws; (void)ws;
          int G = gridDim.x, bx = blockIdx.x; asm volatile("" : "+s"(G), "+s"(bx));
          bf16_t* H = (bf16_t*)(ws + WS_H); bf16_t* F = (bf16_t*)(ws + WS_F); (void)H; (void)F;
          {
            if (SUB(0)) for (int r = 0; r < 2; ++r) {
                pg8::Gemm g{(const bf16_t*)(ws + WS_UH), (const bf16_t*)(ws + WS_PT), 32 * NCHUNK, 256, 256, 512, 256}; pg8::Order S; S.init(32 * NCHUNK, 256, G, bx, r, 1, 10);
                EpiS5State E{(bf16_t*)(ws + WS_UH), (const float*)(ws + WS_APOW), p.in[6], p.out, l};
                pg8::gemm_phase<EpiS5State, pg8::Order, false, true>(lds, g, S, E);
                __syncthreads();
            }
            if (SUB(1)) lru_pass<1>(p, l, lds, G, bx, nullptr);
        }
        } }
        if (14 * l + 6 + 1 < ph_hi) xcd_barrier(xbar);
    }
    if (PH_ON(14 * l + 7)) {
      _Pragma("unroll") for (int rep = 0; rep < REPS[7]; ++rep) { if (rep) xcd_barrier(xbar);
        { CParams* kq = kp; asm volatile("" : "+s"(kq)); CParams& p = *kq; unsigned char* ws = p.ws; (void)ws;
          int G = gridDim.x, bx = blockIdx.x; asm volatile("" : "+s"(G), "+s"(bx));
          bf16_t* H = (bf16_t*)(ws + WS_H); bf16_t* F = (bf16_t*)(ws + WS_F); (void)H; (void)F;
          {
            lru_carry(p, l, G, bx);
            if (PROBE_ATT) { for (int u = bx; u < 1280; u += G) attn_unit(p, l, u, lds, (bf16_t*)(ws + WS_S5Y)); }
            for (int u = bx; u < 1280; u += G) attn_unit(p, l, u, lds, (bf16_t*)(ws + WS_QB));
        }
        } }
        if (14 * l + 7 + 1 < ph_hi) xcd_barrier(xbar);
    }
    if (PH_ON(14 * l + 8)) {
      _Pragma("unroll") for (int rep = 0; rep < REPS[8]; ++rep) { if (rep) xcd_barrier(xbar);
        { CParams* kq = kp; asm volatile("" : "+s"(kq)); CParams& p = *kq; unsigned char* ws = p.ws; (void)ws;
          int G = gridDim.x, bx = blockIdx.x; asm volatile("" : "+s"(G), "+s"(bx));
          bf16_t* H = (bf16_t*)(ws + WS_H); bf16_t* F = (bf16_t*)(ws + WS_F); (void)H; (void)F;
          {
            if (PROBE_MIXB) { lru_pass<3>(p, l, lds, G, bx, (bf16_t*)(ws + WS_F + 40 * MiB)); }
            lru_pass<3>(p, l, lds, G, bx, (bf16_t*)(ws + WS_YL));
            if (SUB(0)) {
            pg8::Gemm g{(const bf16_t*)(ws + WS_UH), (const bf16_t*)(ws + WS_TT), 32 * NCHUNK, 256, 512, 512, 512}; pg8::Order S; S.init(32 * NCHUNK, 256, G, bx, 0, 1 << 30, 10);
            EpiS5Out E{(const bf16_t*)(ws + WS_UH), (bf16_t*)(ws + WS_S5Y), p.in[30] + (size_t)l * 512};
            pg8::gemm_phase<EpiS5Out, pg8::Order, true, true>(lds, g, S, E); }
        }
        } }
        if (14 * l + 8 + 1 < ph_hi) xcd_barrier(xbar);
    }
    if (PH_ON(14 * l + 9)) {
      _Pragma("unroll") for (int rep = 0; rep < REPS[9]; ++rep) { if (rep) xcd_barrier(xbar);
        { CParams* kq = kp; asm volatile("" : "+s"(kq)); CParams& p = *kq; unsigned char* ws = p.ws; (void)ws;
          int G = gridDim.x, bx = blockIdx.x; asm volatile("" : "+s"(G), "+s"(bx));
          bf16_t* H = (bf16_t*)(ws + WS_H); bf16_t* F = (bf16_t*)(ws + WS_F); (void)H; (void)F;
          {
            pg8::u32x4* scr = (pg8::u32x4*)(ws + WS_SCR) + (size_t)bx * 16384;
            const int nr = (G == 256) ? 2 : 3, mrows = (G == 256) ? MSPLIT : M;
            for (int r = 0; r < nr; ++r) { pg8::Order S; S.init(mrows, D, G, bx, r, 1); merge_chain<pg8::Order>(lds, ws, H, scr, S); }
          }
        } }
        if (14 * l + 9 + 1 < ph_hi) xcd_barrier(xbar);
    }
    if (PH_ON(14 * l + 10)) {
      _Pragma("unroll") for (int rep = 0; rep < REPS[10]; ++rep) { if (rep) xcd_barrier(xbar);
        { CParams* kq = kp; asm volatile("" : "+s"(kq)); CParams& p = *kq; unsigned char* ws = p.ws; (void)ws;
          int G = gridDim.x, bx = blockIdx.x; asm volatile("" : "+s"(G), "+s"(bx));
          bf16_t* H = (bf16_t*)(ws + WS_H); bf16_t* F = (bf16_t*)(ws + WS_F); (void)H; (void)F;
          {
            const bf16_t* MGc = (const bf16_t*)(ws + WS_MERGED); const bf16_t* WO = (const bf16_t*)(ws + WS_WOUT);
            if (G == 256) {
                if (bx < 128) { pg8::u32x4* scr = (pg8::u32x4*)(ws + WS_SCR) + (size_t)bx * 16384; OneUnit S{128 + (bx >> 2), bx & 3}; merge_chain<OneUnit>(lds, ws, H, scr, S); }
                else {
                    pg8::Gemm g{MGc, WO, MSPLIT, D, D, D, D}; PanelOrder S{bx - 128}; EpiPlain E{H, D}; pg8::gemm_phase<EpiPlain, PanelOrder, true, true>(lds, g, S, E);
                    asm volatile("s_waitcnt vmcnt(0)" ::: "memory"); __syncthreads();
                    row_phase(p, l, 2, 1, 0, (bx - 128) * 256, (bx - 128) * 256 + 256);
                }
                xcd_barrier(xbar);
                gemm_n1024_halves(lds, MGc, WO, D, H, (bf16_t*)(ws + WS_F2), G, bx);
            } else gemm_n1024_splitk(lds, MGc, WO, D, H, (bf16_t*)(ws + WS_F2), G, bx);
        }
        } }
        if (14 * l + 10 + 1 < ph_hi) xcd_barrier(xbar);
    }
    if (PH_ON(14 * l + 11)) {
      _Pragma("unroll") for (int rep = 0; rep < REPS[11]; ++rep) { if (rep) xcd_barrier(xbar);
        { CParams* kq = kp; asm volatile("" : "+s"(kq)); CParams& p = *kq; unsigned char* ws = p.ws; (void)ws;
          int G = gridDim.x, bx = blockIdx.x; asm volatile("" : "+s"(G), "+s"(bx));
          bf16_t* H = (bf16_t*)(ws + WS_H); bf16_t* F = (bf16_t*)(ws + WS_F); (void)H; (void)F;
          if (G == 256) row_phase(p, l, 2, G, bx, MSPLIT, M); else row_phase(p, l, 2, G, bx);
        } }
        if (14 * l + 11 + 1 < ph_hi) xcd_barrier(xbar);
    }
    if (PH_ON(14 * l + 12)) {
      _Pragma("unroll") for (int rep = 0; rep < REPS[12]; ++rep) { if (rep) xcd_barrier(xbar);
        { CParams* kq = kp; asm volatile("" : "+s"(kq)); CParams& p = *kq; unsigned char* ws = p.ws; (void)ws;
          int G = gridDim.x, bx = blockIdx.x; asm volatile("" : "+s"(G), "+s"(bx));
          bf16_t* H = (bf16_t*)(ws + WS_H); bf16_t* F = (bf16_t*)(ws + WS_F); (void)H; (void)F;
          {
            pg8::Gemm g{H, (const bf16_t*)(ws + WS_WGU1), M, 2 * FF, D, D, D}; pg8::Order S; S.init(M, 2 * FF, G, bx);
            EpiSwiGLU E{(bf16_t*)(ws + WS_ACT)};
            pg8::gemm_phase<EpiSwiGLU, pg8::Order, true, true>(lds, g, S, E);
        }
        } }
        if (14 * l + 12 + 1 < ph_hi) xcd_barrier(xbar);
    }
    if (PH_ON(14 * l + 13)) {
      _Pragma("unroll") for (int rep = 0; rep < REPS[13]; ++rep) { if (rep) xcd_barrier(xbar);
        { CParams* kq = kp; asm volatile("" : "+s"(kq)); CParams& p = *kq; unsigned char* ws = p.ws; (void)ws;
          int G = gridDim.x, bx = blockIdx.x; asm volatile("" : "+s"(G), "+s"(bx));
          bf16_t* H = (bf16_t*)(ws + WS_H); bf16_t* F = (bf16_t*)(ws + WS_F); (void)H; (void)F;
          {
            gemm_n1024_splitk(lds, (const bf16_t*)(ws + WS_ACT), (const bf16_t*)(ws + WS_WD1), FF, F, (bf16_t*)(ws + WS_F2), G, bx);
        }
        } }
        if (14 * l + 13 + 1 < ph_hi) xcd_barrier(xbar);
    }
}
__global__ void __launch_bounds__(NT, 2) fwd_kernel(Params p_unused) {
    extern __shared__ __attribute__((aligned(16))) unsigned char lds_raw[];
    LAS unsigned char* lds = (LAS unsigned char*)lds_raw;
    cg::grid_group grid = cg::this_grid();
    CParams* kp = (CParams*)__builtin_amdgcn_kernarg_segment_ptr();
    const int ph_lo = kp->ph_lo, ph_hi = kp->ph_hi;
    volatile LAS unsigned* misc = (volatile LAS unsigned*)(lds + MISC_OFF);
    if (threadIdx.x < 16) misc[threadIdx.x] = 0u;
    __syncthreads();
    XcdBarrier xbar; xbar.bar = (unsigned*)kp->ws + 1024; xbar.x = 0; xbar.st = nullptr;
    if (ph_hi - ph_lo > 1) xbar = xcd_barrier_post((unsigned*)kp->ws + 1024, misc + 8);
    run_layer<0>(kp, ph_lo, ph_hi, lds, grid, xbar);
    run_layer<1>(kp, ph_lo, ph_hi, lds, grid, xbar);
    for (int e = 0; e < EXTRA_SYNCS; ++e) xcd_barrier(xbar);
    if (PH_ON(28)) { CParams* kq = kp; asm volatile("" : "+s"(kq)); CParams& p = *kq; int G = gridDim.x, bx = blockIdx.x; asm volatile("" : "+s"(G), "+s"(bx)); row_phase(p, 1, 3, G, bx); }
}

extern "C" void kernel_launch(void* const* d_in, const int* in_sizes, int n_in, void* d_out, int out_size, void* d_ws, size_t ws_size, hipStream_t stream) {
    static int grid = 0;
    if (grid == 0) {
        if (n_in != 36 || ws_size < WS_END) { fprintf(stderr, "kernel_launch: n_in %d ws %zu (need %zu)\n", n_in, ws_size, (size_t)WS_END); grid = -1; return; }
        int dev = 0, cus = 0, per_cu = 0;
        hipGetDevice(&dev); hipDeviceGetAttribute(&cus, hipDeviceAttributeMultiprocessorCount, dev);
        if (hipFuncSetAttribute((const void*)fwd_kernel, hipFuncAttributeMaxDynamicSharedMemorySize, LDS_BYTES) != hipSuccess) { fprintf(stderr, "kernel_launch: hipFuncSetAttribute failed\n"); grid = -1; return; }
        hipOccupancyMaxActiveBlocksPerMultiprocessor(&per_cu, (const void*)fwd_kernel, NT, LDS_BYTES);
        (void)hipGetLastError();
        if (per_cu < 1) per_cu = 1;
        grid = cus * 1;
    }
    if (grid < 0) return;
    if (hipMemsetAsync(d_ws, 0, 20480, stream) != hipSuccess) { fprintf(stderr, "kernel_launch: memset failed\n"); return; }
    Params p{};
    for (int i = 0; i < 36; ++i) p.in[i] = (const float*)d_in[i];
    p.out = (float*)d_out; p.ws = (unsigned char*)d_ws;
#if MK_SPLIT
    for (int ph = 0; ph < NPHASE; ++ph) { p.ph_lo = ph; p.ph_hi = ph + 1; void* args[] = {&p};
        hipError_t e = hipLaunchCooperativeKernel((const void*)fwd_kernel, dim3(grid), dim3(NT), args, LDS_BYTES, stream);
        if (e != hipSuccess) { fprintf(stderr, "launch %d failed: %s\n", ph, hipGetErrorString(e)); break; } }
#else
    p.ph_lo = 0; p.ph_hi = NPHASE; void* args[] = {&p};
    hipError_t e = hipLaunchCooperativeKernel((const void*)fwd_kernel, dim3(grid), dim3(NT), args, LDS_BYTES, stream);
    if (e != hipSuccess) fprintf(stderr, "cooperative launch failed: %s (grid %d)\n", hipGetErrorString(e), grid);
#endif
}
```
